# Optimizing an MI355X kernel written in HIP

```python
import math
import jax
import jax.numpy as jnp
from jax import lax
import numpy as np

D_MODEL = 1024
BATCH = 2
SEQ = 16384
DEPTH = 2

HEAD_DIM = 64
N_MIX_HEADS = D_MODEL // HEAD_DIM
GLA_HEADS = N_MIX_HEADS // 4
MOBA_HEADS = N_MIX_HEADS // 2
RWKV_HEADS = N_MIX_HEADS - GLA_HEADS - MOBA_HEADS
GLA_W = GLA_HEADS * HEAD_DIM
MOBA_W = MOBA_HEADS * HEAD_DIM
RWKV_W = RWKV_HEADS * HEAD_DIM
D_MIX = GLA_W + MOBA_W + RWKV_W

GLA_LOWRANK = 16
GLA_TAU = 16.0
GLA_CHUNK = 64

MOBA_BLOCK = 256
MOBA_TOPK = 3
Q_CHUNK = 128

RWKV_LORA = 32
RWKV_GN_EPS = 64e-5

N_BUCKETS = 32
MAX_DISTANCE = 4096
LN_EPS = 1e-5

DN_ALPHA = (2.0 * DEPTH) ** 0.25
DN_BETA = (8.0 * DEPTH) ** -0.25

GLA_COLS = 4 * GLA_W + GLA_LOWRANK
MOBA_COLS = 4 * MOBA_W
RWKV_COLS = 4 * RWKV_W + 2 * RWKV_LORA
D_IN = GLA_COLS + MOBA_COLS + RWKV_COLS

kernel_name = "hymba_style_gla_moba_rwkv7_deepnorm"


def _split(t, sizes):
    idx = [int(v) for v in np.cumsum(sizes)[:-1]]
    return jnp.split(t, idx, axis=-1)


def _to_heads(t, n_heads):
    b, s, _ = t.shape
    return t.reshape(b, s, n_heads, HEAD_DIM).transpose(0, 2, 1, 3)


def _from_heads(t):
    b, n, s, d = t.shape
    return t.transpose(0, 2, 1, 3).reshape(b, s, n * d)


def _layer_norm(x, w, b):
    xf = x.astype(jnp.float32)
    mu = jnp.mean(xf, axis=-1, keepdims=True)
    var = jnp.mean(jnp.square(xf - mu), axis=-1, keepdims=True)
    return (xf - mu) * lax.rsqrt(var + LN_EPS) * w + b


def _t5_bucket(rel):
    rel = jnp.maximum(rel, 0)
    max_exact = N_BUCKETS // 2
    rel_f = jnp.maximum(rel, 1).astype(jnp.float32)
    large = max_exact + (jnp.log(rel_f / max_exact) / math.log(MAX_DISTANCE / max_exact)
                         * (N_BUCKETS - max_exact)).astype(jnp.int32)
    large = jnp.minimum(large, N_BUCKETS - 1)
    return jnp.where(rel < max_exact, rel, large)


def _gla_chunked(q, k, v, log_a):
    b, h, s, dk = q.shape
    dv = v.shape[-1]
    n = s // GLA_CHUNK

    def chunks(t):
        return t.reshape(b, h, n, GLA_CHUNK, t.shape[-1]).transpose(2, 0, 1, 3, 4)

    causal = jnp.tril(jnp.ones((GLA_CHUNK, GLA_CHUNK), dtype=bool))[:, :, None]

    def step(state, inp):
        qc, kc, vc, gc = inp
        cum = jnp.cumsum(gc, axis=-2)
        o_inter = jnp.einsum('bhtk,bhkv->bhtv', qc * jnp.exp(cum), state)
        diff = cum[:, :, :, None, :] - cum[:, :, None, :, :]
        decay = jnp.exp(jnp.where(causal, diff, -jnp.inf))
        scores = jnp.einsum('bhtk,bhsk,bhtsk->bhts', qc, kc, decay)
        o_intra = jnp.einsum('bhts,bhsv->bhtv', scores, vc)
        last = cum[:, :, -1:, :]
        state = state * jnp.exp(last[:, :, 0, :])[..., None] + jnp.einsum(
            'bhsk,bhsv->bhkv', kc * jnp.exp(last - cum), vc)
        return state, o_inter + o_intra

    s0 = jnp.zeros((b, h, dk, dv), jnp.float32)
    _, out = lax.scan(step, s0, (chunks(q), chunks(k), chunks(v), chunks(log_a)))
    return out.transpose(1, 2, 0, 3, 4).reshape(b, h, s, dv)


def _gla_branch(hg, a_up, a_bias, norm_w):
    hg = hg.astype(jnp.float32)
    q, k, v, g, a_dn = _split(hg, [GLA_W] * 4 + [GLA_LOWRANK])
    log_a = jax.nn.log_sigmoid(a_dn @ a_up.astype(jnp.float32) + a_bias) / GLA_TAU
    o = _gla_chunked(_to_heads(q, GLA_HEADS) * HEAD_DIM ** -0.5, _to_heads(k, GLA_HEADS),
                     _to_heads(v, GLA_HEADS), _to_heads(log_a, GLA_HEADS))
    o = o * lax.rsqrt(jnp.mean(jnp.square(o), axis=-1, keepdims=True) + LN_EPS) * norm_w
    return _from_heads(o) * jax.nn.silu(g)


def _moba_attention(q, k, v, rel_bias):
    b, h, s, dh = q.shape
    nb = -(-s // MOBA_BLOCK)
    pad = nb * MOBA_BLOCK - s
    kp = jnp.pad(k, ((0, 0), (0, 0), (0, pad), (0, 0))).reshape(b, h, nb, MOBA_BLOCK, dh)
    vp = jnp.pad(v, ((0, 0), (0, 0), (0, pad), (0, 0))).reshape(b, h, nb, MOBA_BLOCK, dh)
    kbar = jnp.mean(kp, axis=3)
    top = min(MOBA_TOPK, nb)
    nq = s // Q_CHUNK
    q_chunks = q.reshape(b, h, nq, Q_CHUNK, dh).transpose(2, 0, 1, 3, 4)
    bias_tab = rel_bias.T.astype(jnp.float32)
    b_idx = jnp.arange(b)[:, None, None, None]
    h_idx = jnp.arange(h)[None, :, None, None]
    blk_ar = jnp.arange(MOBA_BLOCK)
    blocks = jnp.arange(nb)
    scale = dh ** -0.5

    def one_chunk(args):
        qi, ci = args
        q_pos = ci * Q_CHUNK + jnp.arange(Q_CHUNK)
        own = (ci * Q_CHUNK) // MOBA_BLOCK
        gate = jnp.einsum('bhqd,bhnd->bhqn', qi, kbar)
        gate = jnp.where(blocks < own, gate, -jnp.inf)
        _, idx = lax.top_k(gate, top)
        valid = idx < own
        k_sel = kp[b_idx, h_idx, idx]
        v_sel = vp[b_idx, h_idx, idx]
        kpos_sel = idx[..., None] * MOBA_BLOCK + blk_ar
        bias_sel = bias_tab[h_idx[..., None], _t5_bucket(q_pos[:, None, None] - kpos_sel)]
        s_sel = jnp.einsum('bhqd,bhqjkd->bhqjk', qi, k_sel) * scale + bias_sel
        s_sel = jnp.where(valid[..., None], s_sel, -jnp.inf)
        k_own = lax.dynamic_index_in_dim(kp, own, axis=2, keepdims=False)
        v_own = lax.dynamic_index_in_dim(vp, own, axis=2, keepdims=False)
        rel_own = q_pos[:, None] - (own * MOBA_BLOCK + blk_ar)[None, :]
        s_own = jnp.einsum('bhqd,bhkd->bhqk', qi, k_own) * scale + bias_tab[:, _t5_bucket(rel_own)]
        s_own = jnp.where(rel_own >= 0, s_own, -jnp.inf)
        logits = jnp.concatenate([s_sel.reshape(b, h, Q_CHUNK, top * MOBA_BLOCK), s_own], axis=-1)
        p = jax.nn.softmax(logits, axis=-1)
        p_sel = p[..., :top * MOBA_BLOCK].reshape(b, h, Q_CHUNK, top, MOBA_BLOCK)
        p_own = p[..., top * MOBA_BLOCK:]
        return (jnp.einsum('bhqjk,bhqjkd->bhqd', p_sel, v_sel)
                + jnp.einsum('bhqk,bhkd->bhqd', p_own, v_own))

    out = lax.map(one_chunk, (q_chunks, jnp.arange(nq)))
    return out.transpose(1, 2, 0, 3, 4).reshape(b, h, s, dh)


def _moba_branch(hm, rel_bias):
    hm = hm.astype(jnp.float32)
    q, k, v, g = _split(hm, [MOBA_W] * 4)
    o = _moba_attention(_to_heads(q, MOBA_HEADS), _to_heads(k, MOBA_HEADS),
                        _to_heads(v, MOBA_HEADS), rel_bias)
    return _from_heads(o) * jax.nn.silu(g)


def _rwkv7_scan(r, w, k, v, aa, bb):
    b, s, h, d = r.shape

    def step(state, inp):
        rt, wt, kt, vt, at, bt = inp
        sa = jnp.einsum('bhvk,bhk->bhv', state, at)
        state = state * wt[:, :, None, :] + sa[..., None] * bt[:, :, None, :] + vt[..., None] * kt[:, :, None, :]
        return state, jnp.einsum('bhvk,bhk->bhv', state, rt)

    xs = tuple(jnp.moveaxis(t, 1, 0) for t in (r, w, k, v, aa, bb))
    _, y = lax.scan(step, jnp.zeros((b, h, d, d), jnp.float32), xs)
    return jnp.moveaxis(y, 0, 1)


def _rwkv_branch(hr, mu, w_up, w0, a_up, a0, k_k, k_a, r_k, gn_w, gn_b):
    b, s, _ = hr.shape
    f32 = jnp.float32
    p = hr.astype(f32)
    p_prev = jnp.pad(p, ((0, 0), (1, 0), (0, 0)))[:, :-1]
    p = p + (p_prev - p) * mu
    r, k, v, g, w_dn, a_dn = _split(p, [RWKV_W] * 4 + [RWKV_LORA] * 2)
    d = w0 + jnp.tanh(w_dn) @ w_up.astype(f32)
    decay = jnp.exp(-jnp.exp(-jax.nn.softplus(-d) - 0.5))
    a = jax.nn.sigmoid(a0 + a_dn @ a_up.astype(f32))
    hs = lambda t: t.reshape(b, s, RWKV_HEADS, HEAD_DIM)
    hv = lambda t: t.reshape(RWKV_HEADS, HEAD_DIM)
    kk = hs(k * k_k)
    kk = kk / jnp.maximum(jnp.sqrt(jnp.sum(jnp.square(kk), axis=-1, keepdims=True)), 1e-12)
    k = k * (1.0 + (a - 1.0) * k_a)
    r_h, w_h, k_h, v_h, a_h = hs(r), hs(decay), hs(k), hs(v), hs(a)
    y = _rwkv7_scan(r_h, w_h, k_h, v_h, -kk, kk * a_h)
    ym = jnp.mean(y, axis=-1, keepdims=True)
    yv = jnp.mean(jnp.square(y - ym), axis=-1, keepdims=True)
    y = (y - ym) * lax.rsqrt(yv + RWKV_GN_EPS) * hv(gn_w) + hv(gn_b)
    y = y + jnp.sum(r_h * k_h * hv(r_k), axis=-1, keepdims=True) * v_h
    return y.reshape(b, s, RWKV_W) * jax.nn.silu(g)


def _layer(x, w_in, w_out, gla_a_up, gla_a_bias, gla_norm_w, rel_bias, mu, w_up, w0,
           a_up, a0, k_k, k_a, r_k, gn_w, gn_b, ln_w, ln_b):
    h = jnp.einsum('btd,de->bte', x, w_in)
    h_gla, h_moba, h_rwkv = _split(h, [GLA_COLS, MOBA_COLS, RWKV_COLS])
    o = jnp.concatenate([
        _gla_branch(h_gla, gla_a_up, gla_a_bias, gla_norm_w),
        _moba_branch(h_moba, rel_bias),
        _rwkv_branch(h_rwkv, mu, w_up, w0, a_up, a0, k_k, k_a, r_k, gn_w, gn_b),
    ], axis=-1)
    y = jnp.einsum('bte,ed->btd', o, w_out.astype(jnp.float32))
    return _layer_norm(DN_ALPHA * x.astype(jnp.float32) + y, ln_w, ln_b).astype(x.dtype)


def setup_inputs(seed: int = 0) -> dict:
    key = jax.random.key(seed)
    ks = jax.random.split(key, 20)
    L = DEPTH
    f32 = jnp.float32
    nrm = lambda k_, shp: jax.random.normal(k_, shp, f32)
    col_scale = jnp.ones((D_IN,), f32)
    for start, width in ((2 * GLA_W, GLA_W), (GLA_COLS + 2 * MOBA_W, MOBA_W),
                         (GLA_COLS + MOBA_COLS + 2 * RWKV_W, RWKV_W)):
        col_scale = col_scale.at[start:start + width].set(DN_BETA)
    return {
        "x": nrm(ks[0], (BATCH, SEQ, D_MODEL)),
        "w_in": nrm(ks[1], (L, D_MODEL, D_IN)) * D_MODEL ** -0.5 * col_scale,
        "w_out": nrm(ks[2], (L, D_MIX, D_MODEL)) * D_MIX ** -0.5 * DN_BETA,
        "gla_a_up": nrm(ks[3], (L, GLA_LOWRANK, GLA_W)) * GLA_LOWRANK ** -0.5,
        "gla_a_bias": nrm(ks[4], (L, GLA_W)) * 0.5,
        "gla_norm_w": 1.0 + 0.05 * nrm(ks[5], (L, HEAD_DIM)),
        "moba_rel_bias": nrm(ks[6], (N_BUCKETS, MOBA_HEADS)) * 0.5,
        "rwkv_mu": jax.random.uniform(ks[7], (L, RWKV_COLS), f32),
        "rwkv_w_up": nrm(ks[8], (L, RWKV_LORA, RWKV_W)) * 0.1,
        "rwkv_w0": jax.random.uniform(ks[9], (L, RWKV_W), f32, -6.0, 1.0),
        "rwkv_a_up": nrm(ks[10], (L, RWKV_LORA, RWKV_W)) * 0.5 * RWKV_LORA ** -0.5,
        "rwkv_a0": nrm(ks[11], (L, RWKV_W)) * 0.5,
        "rwkv_k_k": 0.85 + 0.05 * nrm(ks[12], (L, RWKV_W)),
        "rwkv_k_a": 1.0 + 0.05 * nrm(ks[13], (L, RWKV_W)),
        "rwkv_r_k": nrm(ks[14], (L, RWKV_W)) * 0.1,
        "rwkv_gn_w": 1.0 + 0.05 * nrm(ks[15], (L, RWKV_W)),
        "rwkv_gn_b": 0.02 * nrm(ks[16], (L, RWKV_W)),
        "ln_w": 1.0 + 0.05 * nrm(ks[17], (L, D_MODEL)),
        "ln_b": 0.02 * nrm(ks[18], (L, D_MODEL)),
    }


def reference(x, w_in, w_out, gla_a_up, gla_a_bias, gla_norm_w, moba_rel_bias, rwkv_mu,
              rwkv_w_up, rwkv_w0, rwkv_a_up, rwkv_a0, rwkv_k_k, rwkv_k_a, rwkv_r_k,
              rwkv_gn_w, rwkv_gn_b, ln_w, ln_b):
    for l in range(DEPTH):
        x = _layer(x, w_in[l], w_out[l], gla_a_up[l], gla_a_bias[l], gla_norm_w[l], moba_rel_bias,
                   rwkv_mu[l], rwkv_w_up[l], rwkv_w0[l], rwkv_a_up[l], rwkv_a0[l], rwkv_k_k[l],
                   rwkv_k_a[l], rwkv_r_k[l], rwkv_gn_w[l], rwkv_gn_b[l], ln_w[l], ln_b[l])
    return x
```

```cpp
#include <hip/hip_runtime.h>
#include <cstdio>
#include <cstdint>
#include <cmath>
namespace pg8 {
#define PG8_LAS __attribute__((address_space(3)))
typedef unsigned short bf16_t;
typedef short bf16x8 __attribute__((ext_vector_type(8)));
typedef float f32x4 __attribute__((ext_vector_type(4)));
typedef unsigned u32x4 __attribute__((ext_vector_type(4)));
constexpr int BM = 256, BK = 64, HALF = 128, HTB = HALF * BK * 2  , STAGE_BYTES = 8 * HTB, NXCD = 8, WGM = 8;

__host__ __device__ __forceinline__ int lds_byte(int r, int c) { const int st = (r >> 4) * 2 + (c >> 5), rr = r & 15, cc = c & 31, ob = rr * 64 + cc * 2; return st * 1024 + (ob ^ (((ob >> 9) & 1) << 5)); }
__host__ __device__ __forceinline__ void stage_rc(int b, int& R, int& C) { const int st = b / 1024, sb = b % 1024, swz = sb ^ (((sb >> 9) & 1) << 5); R = (st >> 1) * 16 + swz / 64; C = (st & 1) * 32 + (swz % 64) / 2; }
__host__ __device__ __forceinline__ int perm32(int rho) { const int n = rho >> 4, i = rho & 15; return 8 * (i >> 2) + 4 * n + (i & 3); }

struct Unit { int pm, pn; };
struct Gemm { const bf16_t* A; const bf16_t* Bt; int M, N, K; };

struct StaticOrder {
    int nM, nN, nwg, G, c;
    __host__ __device__ void init(int M, int N, int G_, int c_) { nM = M / BM; nN = N / BM; nwg = nM * nN; G = G_; c = c_; }
    __host__ __device__ bool next(int i, Unit& u) const {
        const long L = (long)i * G + c; if (L >= nwg) return false;
        int wgid = (int)L; { const int q = nwg / NXCD, r = nwg % NXCD, xcd = wgid % NXCD, off = wgid / NXCD; wgid = (xcd < r ? xcd * (q + 1) : r * (q + 1) + (xcd - r) * q) + off; }
        const int nig = WGM * nN, gid = wgid / nig, fm = gid * WGM, gsz = (nM - fm) < WGM ? (nM - fm) : WGM;
        u.pm = fm + ((wgid % nig) % gsz); u.pn = (wgid % nig) / gsz; return true;
    }
    __device__ __forceinline__ void a_ready(const Unit&) const {}
    __device__ __forceinline__ void done(const Unit&) const {}
};

__device__ __forceinline__ unsigned cvt_pk_bf16(float lo, float hi) { unsigned r; asm volatile("v_cvt_pk_bf16_f32 %0, %1, %2" : "=v"(r) : "v"(lo), "v"(hi)); return r; }
typedef float f32x2 __attribute__((ext_vector_type(2)));
__device__ __forceinline__ f32x2 gelu_pk(f32x2 v) {
    const f32x2 av = __builtin_elementwise_abs(v), d = av * 0.2316418882f + 1.0f;
    f32x2 t; t.x = __builtin_amdgcn_rcpf(d.x); t.y = __builtin_amdgcn_rcpf(d.y);
    f32x2 q = t * 0.5307027145f + (-0.7265760135f); q = q * t + 0.7107068705f; q = q * t + (-0.142248368f); q = q * t + 0.127414796f; q = q * t;
    const f32x2 s = (v * v) * (-0.72134752044f);
    f32x2 e; e.x = __builtin_amdgcn_exp2f(s.x); e.y = __builtin_amdgcn_exp2f(s.y);
    const f32x2 m = v * (q * e), r = v - m;
    f32x2 o; o.x = v.x < 0.f ? m.x : r.x; o.y = v.y < 0.f ? m.y : r.y; return o;
}

template <int ACT  > struct EpiBf16 {
    static constexpr bool PERM = true, AFTER_DRAIN = false; static_assert(ACT == 0 || ACT == 1, "EpiBf16: ACT is 0 (none) or 1 (gelu_pk)");
    bf16_t* O; int ldc; const float* bias; int split_cols; size_t split_stride; float scale0;
    __device__ __forceinline__ void operator()(const f32x4 (&acc)[2][2][4][2], const Unit& u, int wr, int wc, int fr, int fq) const {
        const int row0 = u.pm * BM + wr * 64 + fr; int colt = u.pn * BM; bf16_t* base = O;
        float sc = 1.f; if (split_cols) { const int t = colt / split_cols; base += (size_t)t * split_stride; colt -= t * split_cols; if (t == 0) sc = scale0; }
        const int col0 = colt + wc * 32 + 8 * fq, bcol0 = u.pn * BM + wc * 32 + 8 * fq;
        f32x4 bv[2][2];
#pragma unroll
        for (int bj = 0; bj < 2; ++bj)
#pragma unroll
            for (int n = 0; n < 2; ++n) bv[bj][n] = bias ? *(const f32x4*)(bias + bcol0 + bj * HALF + 4 * n) : (f32x4){0.f, 0.f, 0.f, 0.f};
#pragma unroll
        for (int ai = 0; ai < 2; ++ai)
#pragma unroll
            for (int m = 0; m < 4; ++m) { bf16_t* rowp = base + (size_t)(row0 + ai * HALF + m * 16) * ldc + col0;
#pragma unroll
                for (int bj = 0; bj < 2; ++bj) { f32x4 v0 = acc[ai][bj][m][0] + bv[bj][0], v1 = acc[ai][bj][m][1] + bv[bj][1];
                    if (ACT == 1) { f32x2 a = gelu_pk((f32x2){v0[0], v0[1]}), b = gelu_pk((f32x2){v0[2], v0[3]}), c = gelu_pk((f32x2){v1[0], v1[1]}), d = gelu_pk((f32x2){v1[2], v1[3]});
                        v0 = (f32x4){a.x, a.y, b.x, b.y}; v1 = (f32x4){c.x, c.y, d.x, d.y}; }
                    v0 = v0 * sc; v1 = v1 * sc; u32x4 w; w.x = cvt_pk_bf16(v0[0], v0[1]); w.y = cvt_pk_bf16(v0[2], v0[3]); w.z = cvt_pk_bf16(v1[0], v1[1]); w.w = cvt_pk_bf16(v1[2], v1[3]);
                    *(u32x4*)(rowp + bj * HALF) = w; } }
    }
};
struct EpiF32 {
    static constexpr bool PERM = false, AFTER_DRAIN = false;
    float* C; int ldc; const float* bias;
    __device__ __forceinline__ void operator()(const f32x4 (&acc)[2][2][4][2], const Unit& u, int wr, int wc, int fr, int fq) const {
        const int row0 = u.pm * BM + wr * 64 + fr, col0 = u.pn * BM + wc * 32 + 4 * fq;
        f32x4 bv[2][2];
#pragma unroll
        for (int bj = 0; bj < 2; ++bj)
#pragma unroll
            for (int n = 0; n < 2; ++n) bv[bj][n] = bias ? *(const f32x4*)(bias + col0 + bj * HALF + n * 16) : (f32x4){0.f, 0.f, 0.f, 0.f};
#pragma unroll
        for (int ai = 0; ai < 2; ++ai)
#pragma unroll
            for (int m = 0; m < 4; ++m) { float* rowp = C + (size_t)(row0 + ai * HALF + m * 16) * ldc + col0;
#pragma unroll
                for (int bj = 0; bj < 2; ++bj)
#pragma unroll
                    for (int n = 0; n < 2; ++n) *(f32x4*)(rowp + bj * HALF + n * 16) = acc[ai][bj][m][n] + bv[bj][n]; }
    }
};
template <class Epi, class Sched, bool ALIGN_EPI = false, bool SP2 = false>
__device__ __forceinline__ void gemm_phase(PG8_LAS unsigned char* lds, const Gemm g, const Sched& S, const Epi& E) {
    const int tid = threadIdx.x, wid = __builtin_amdgcn_readfirstlane(tid >> 6), lane = tid & 63, wr = wid >> 2, wc = wid & 3, fr = lane & 15, fq = lane >> 4;
    const int K = g.K, nt = K / BK;
    unsigned voffA[2], voffB[2];
#pragma unroll
    for (int i = 0; i < 2; ++i) { int R, C; stage_rc(tid * 16 + i * 8192, R, C); const int Rb = Epi::PERM ? ((R & ~31) + perm32(R & 31)) : R;
        voffA[i] = (unsigned)(R * K + C) * 2u; voffB[i] = (unsigned)(Rb * K + C) * 2u; }
    const size_t kstep = (size_t)(BK * 2);
    const size_t hstep = (size_t)HALF * K * 2;
    const size_t tstep = 2 * hstep;
    const unsigned ldsw = (unsigned)wid * 1024u;
    const int aoff = lds_byte(wr * 64 + fr, fq * 8), boff = lds_byte(wc * 32 + fr, fq * 8);
#define PG8_SA(b, h) (((b) * 2 + (h)) * HTB)
#define PG8_SB(b, h) ((4 + (b) * 2 + (h)) * HTB)
#define PG8_STAGE(bufoff, gbase, voff) do { _Pragma("unroll") for (int _i = 0; _i < 2; ++_i) \
        __builtin_amdgcn_global_load_lds((const unsigned*)((const char*)(gbase) + (voff)[_i]), (PG8_LAS unsigned*)(lds + (bufoff) + ldsw + _i * 8192), 16, 0, 0); } while (0)
#define PG8_LDA(dst, b, h) do { _Pragma("unroll") for (int m = 0; m < 4; ++m) _Pragma("unroll") for (int k = 0; k < 2; ++k) dst[m][k] = *(const PG8_LAS bf16x8*)(lds + PG8_SA(b, h) + aoff + m * 2048 + k * 1024); } while (0)
#define PG8_LDB(dst, b, h) do { _Pragma("unroll") for (int n = 0; n < 2; ++n) _Pragma("unroll") for (int k = 0; k < 2; ++k) dst[n][k] = *(const PG8_LAS bf16x8*)(lds + PG8_SB(b, h) + boff + n * 2048 + k * 1024); } while (0)
#define PG8_MMA(ai, bj, At, Bt) do { __builtin_amdgcn_s_setprio(1); _Pragma("unroll") for (int m = 0; m < 4; ++m) _Pragma("unroll") for (int n = 0; n < 2; ++n) _Pragma("unroll") for (int k = 0; k < 2; ++k) \
        acc[ai][bj][m][n] = __builtin_amdgcn_mfma_f32_16x16x32_bf16(Bt[n][k], At[m][k], acc[ai][bj][m][n], 0, 0, 0); __builtin_amdgcn_s_setprio(0); } while (0)
#define PG8_WAIT_V(n) asm volatile("s_waitcnt vmcnt(" #n ")" ::: "memory")
#define PG8_WAIT_L(n) asm volatile("s_waitcnt lgkmcnt(" #n ")" ::: "memory")
#define PG8_BAR __builtin_amdgcn_s_barrier()
#define PG8_SCHED __builtin_amdgcn_sched_barrier(0)
    Unit cur, nxt; int ui = 0;
    if (!S.next(0, cur)) return;
    f32x4 acc[2][2][4][2];
#pragma unroll
    for (int a = 0; a < 2; ++a)
#pragma unroll
        for (int b = 0; b < 2; ++b)
#pragma unroll
            for (int m = 0; m < 4; ++m)
#pragma unroll
                for (int n = 0; n < 2; ++n) acc[a][b][m][n] = (f32x4){0.f, 0.f, 0.f, 0.f};
    bf16x8 At[4][2], B0[2][2], B1[2][2];
    const char* cA = (const char*)g.A + (size_t)cur.pm * tstep; const char* cB = (const char*)g.Bt + (size_t)cur.pn * tstep;
    S.a_ready(cur);
    if constexpr (SP2) {
        PG8_STAGE(PG8_SB(0, 0), cB, voffB); PG8_STAGE(PG8_SB(0, 1), cB + hstep, voffB); PG8_STAGE(PG8_SA(0, 0), cA, voffA); PG8_STAGE(PG8_SA(0, 1), cA + hstep, voffA);
        if (wr == 1) PG8_BAR;
        PG8_WAIT_V(2); PG8_BAR;
        PG8_STAGE(PG8_SB(1, 0), cB + kstep, voffB); PG8_STAGE(PG8_SA(1, 0), cA + kstep, voffA); PG8_STAGE(PG8_SB(1, 1), cB + hstep + kstep, voffB);
        PG8_WAIT_V(6); PG8_BAR;
    } else {
        PG8_STAGE(PG8_SB(0, 0), cB, voffB); PG8_STAGE(PG8_SA(0, 0), cA, voffA); PG8_STAGE(PG8_SB(0, 1), cB + hstep, voffB); PG8_STAGE(PG8_SA(0, 1), cA + hstep, voffA);
        if (wr == 1) PG8_BAR;
        PG8_WAIT_V(4); PG8_BAR;
        PG8_STAGE(PG8_SB(1, 0), cB + kstep, voffB); PG8_STAGE(PG8_SA(1, 0), cA + kstep, voffA); PG8_STAGE(PG8_SB(1, 1), cB + hstep + kstep, voffB);
        PG8_WAIT_V(6); PG8_BAR;
    }
    for (;;) {
        const bool has_next = S.next(ui + 1, nxt);
        const char* nA = has_next ? (const char*)g.A + (size_t)nxt.pm * tstep : cA; const char* nB = has_next ? (const char*)g.Bt + (size_t)nxt.pn * tstep : cB;
        for (int t = 0; t < nt; t += 2) {
            const bool last = (t == nt - 2);
            const char* a1 = cA + (size_t)(t + 1) * kstep;
            const char* a2 = last ? nA : cA + (size_t)(t + 2) * kstep; const char* b2 = last ? nB : cB + (size_t)(t + 2) * kstep;
            const char* a3 = a2 + kstep; const char* b3 = b2 + kstep;
            if (last && has_next) S.a_ready(nxt);
            if constexpr (SP2) {
            PG8_LDB(B0, 0, 0); PG8_LDB(B1, 0, 1); PG8_SCHED; PG8_LDA(At, 0, 0); PG8_STAGE(PG8_SA(1, 1), a1 + hstep, voffA);
            PG8_WAIT_V(8); PG8_WAIT_L(0); PG8_BAR; PG8_MMA(0, 0, At, B0); PG8_MMA(0, 1, At, B1); PG8_BAR; PG8_SCHED;
            PG8_LDA(At, 0, 1); PG8_STAGE(PG8_SB(0, 0), b2, voffB); PG8_STAGE(PG8_SB(0, 1), b2 + hstep, voffB); PG8_STAGE(PG8_SA(0, 0), a2, voffA);
            PG8_WAIT_V(8); PG8_WAIT_L(0); PG8_BAR; PG8_MMA(1, 0, At, B0); PG8_MMA(1, 1, At, B1); PG8_BAR; PG8_SCHED;
            PG8_LDB(B0, 1, 0); PG8_LDB(B1, 1, 1); PG8_SCHED; PG8_LDA(At, 1, 0); PG8_STAGE(PG8_SA(0, 1), a2 + hstep, voffA);
            PG8_WAIT_V(8); PG8_WAIT_L(0); PG8_BAR; PG8_MMA(0, 0, At, B0); PG8_MMA(0, 1, At, B1); PG8_BAR; PG8_SCHED;
            PG8_LDA(At, 1, 1); PG8_STAGE(PG8_SB(1, 0), b3, voffB); PG8_STAGE(PG8_SB(1, 1), b3 + hstep, voffB); PG8_STAGE(PG8_SA(1, 0), a3, voffA);
            PG8_WAIT_V(8); PG8_WAIT_L(0); PG8_BAR; PG8_MMA(1, 0, At, B0); PG8_MMA(1, 1, At, B1); PG8_BAR; PG8_SCHED;
            } else {
            PG8_LDB(B0, 0, 0); PG8_SCHED; PG8_LDA(At, 0, 0); PG8_STAGE(PG8_SA(1, 1), a1 + hstep, voffA);
            PG8_WAIT_L(8); PG8_BAR; PG8_WAIT_L(0); PG8_MMA(0, 0, At, B0); PG8_BAR; PG8_SCHED;
            PG8_LDB(B1, 0, 1); PG8_STAGE(PG8_SB(0, 0), b2, voffB);
            PG8_BAR; PG8_WAIT_L(0); PG8_MMA(0, 1, At, B1); PG8_BAR;
            PG8_LDA(At, 0, 1); PG8_STAGE(PG8_SA(0, 0), a2, voffA);
            PG8_BAR; PG8_WAIT_L(0); PG8_MMA(1, 0, At, B0); PG8_BAR; PG8_SCHED;
            PG8_STAGE(PG8_SB(0, 1), b2 + hstep, voffB);
            PG8_WAIT_V(6); PG8_BAR; PG8_MMA(1, 1, At, B1); PG8_BAR;
            PG8_LDB(B0, 1, 0); PG8_SCHED; PG8_LDA(At, 1, 0); PG8_STAGE(PG8_SA(0, 1), a2 + hstep, voffA);
            PG8_WAIT_L(8); PG8_BAR; PG8_WAIT_L(0); PG8_MMA(0, 0, At, B0); PG8_BAR; PG8_SCHED;
            PG8_LDB(B1, 1, 1); PG8_STAGE(PG8_SB(1, 0), b3, voffB);
            PG8_BAR; PG8_WAIT_L(0); PG8_MMA(0, 1, At, B1); PG8_BAR;
            PG8_LDA(At, 1, 1); PG8_STAGE(PG8_SA(1, 0), a3, voffA);
            PG8_BAR; PG8_WAIT_L(0); PG8_MMA(1, 0, At, B0); PG8_BAR; PG8_SCHED;
            PG8_STAGE(PG8_SB(1, 1), b3 + hstep, voffB);
            PG8_WAIT_V(6); PG8_BAR; PG8_MMA(1, 1, At, B1); PG8_BAR;
            }
        }
        if constexpr (ALIGN_EPI) { if (wr == 0) PG8_BAR; }
        if constexpr (!Epi::AFTER_DRAIN) { E(acc, cur, wr, wc, fr, fq); S.done(cur); }
        if (!has_next) break;
#pragma unroll
        for (int a = 0; a < 2; ++a)
#pragma unroll
            for (int b = 0; b < 2; ++b)
#pragma unroll
                for (int m = 0; m < 4; ++m)
#pragma unroll
                    for (int n = 0; n < 2; ++n) acc[a][b][m][n] = (f32x4){0.f, 0.f, 0.f, 0.f};
        cur = nxt; cA = nA; cB = nB; ++ui;
        if constexpr (ALIGN_EPI) { if (wr == 1) PG8_BAR; }
    }
    PG8_WAIT_V(0);
    if constexpr (!ALIGN_EPI) { if (wr == 0) PG8_BAR; }
    PG8_BAR;
    if constexpr (Epi::AFTER_DRAIN) { E.fused(acc, cur, wr, wc, fr, fq, lds, wid, lane); S.done(cur); }
#undef PG8_SA
#undef PG8_SB
#undef PG8_STAGE
#undef PG8_LDA
#undef PG8_LDB
#undef PG8_MMA
#undef PG8_WAIT_V
#undef PG8_WAIT_L
#undef PG8_BAR
#undef PG8_SCHED
}
}
typedef unsigned short bf16;
constexpr int BATCH = 2, SEQ = 16384, DM = 1024, DEPTH = 2, MTOK = BATCH * SEQ;
constexpr int D_IN = 4176, NPAD = 4352;
constexpr int C_GQ = 0, C_GK = 256, C_GV = 512, C_GG = 768, C_GA = 1024;
constexpr int C_MQ = 1040, C_MK = 1552, C_MV = 2064, C_MG = 2576;
constexpr int C_R0 = 3088;
constexpr float DN_ALPHA = 1.4142135623730951f;

__device__ __forceinline__ float bf2f(bf16 u) { return __uint_as_float(((unsigned)u) << 16); }
__device__ __forceinline__ bf16 f2bf(float f) { unsigned u = __float_as_uint(f); return (bf16)((u + 0x7fffu + ((u >> 16) & 1u)) >> 16); }
__device__ __forceinline__ float wave_sum(float v) {
#pragma unroll
    for (int o = 1; o < 64; o <<= 1) v += __shfl_xor(v, o);
    return v;
}
__device__ __forceinline__ float wave_max(float v) {
#pragma unroll
    for (int o = 1; o < 64; o <<= 1) v = fmaxf(v, __shfl_xor(v, o));
    return v;
}
__device__ __forceinline__ float silu_f(float g) { return g / (1.f + __expf(-g)); }
__device__ __forceinline__ float sigmoid_f(float z) { return 1.f / (1.f + __expf(-z)); }

__global__ void __launch_bounds__(256) k_transpose_w(const float* W, int K, int N, bf16* WT) {
    __shared__ float tile[64][65];
    const int n0 = blockIdx.x * 64, k0 = blockIdx.y * 64, tid = threadIdx.x;
    for (int i = 0; i < 16; ++i) { const int k = i * 4 + (tid >> 6), n = tid & 63; tile[k][n] = (n0 + n < N) ? W[(size_t)(k0 + k) * N + n0 + n] : 0.f; }
    __syncthreads();
    for (int i = 0; i < 16; ++i) { const int n = i * 4 + (tid >> 6), k = tid & 63; WT[(size_t)(n0 + n) * K + k0 + k] = f2bf(tile[k][n]); }
}
__global__ void __launch_bounds__(256) k_cvt_x(const float* x, bf16* xn, size_t n8) {
    const size_t i = (size_t)blockIdx.x * 256 + threadIdx.x; if (i >= n8) return;
    const float4 a = ((const float4*)x)[2 * i], b = ((const float4*)x)[2 * i + 1];
    uint4 o; o.x = f2bf(a.x) | ((unsigned)f2bf(a.y) << 16); o.y = f2bf(a.z) | ((unsigned)f2bf(a.w) << 16); o.z = f2bf(b.x) | ((unsigned)f2bf(b.y) << 16); o.w = f2bf(b.z) | ((unsigned)f2bf(b.w) << 16);
    ((uint4*)xn)[i] = o;
}
constexpr int GEMM_LDS = 147456;
__global__ void __launch_bounds__(512, 2) k_gemm_in(const bf16* A, const bf16* Bt, bf16* H) {
    extern __shared__ __attribute__((aligned(16))) unsigned char lds[];
    pg8::Gemm g{A, Bt, MTOK, NPAD, DM};
    pg8::StaticOrder S; S.init(MTOK, NPAD, (int)gridDim.x, (int)blockIdx.x);
    pg8::EpiBf16<0> E{H, NPAD, nullptr, 0, 0, 1.f};
    pg8::gemm_phase<pg8::EpiBf16<0>, pg8::StaticOrder, true, true>((PG8_LAS unsigned char*)lds, g, S, E);
}
__global__ void __launch_bounds__(512, 2) k_gemm_out(const bf16* A, const bf16* Bt, float* Y) {
    extern __shared__ __attribute__((aligned(16))) unsigned char lds[];
    pg8::Gemm g{A, Bt, MTOK, DM, DM};
    pg8::StaticOrder S; S.init(MTOK, DM, (int)gridDim.x, (int)blockIdx.x);
    pg8::EpiF32 E{Y, DM, nullptr};
    pg8::gemm_phase<pg8::EpiF32, pg8::StaticOrder, true, true>((PG8_LAS unsigned char*)lds, g, S, E);
}
__global__ void __launch_bounds__(256) k_ln(const float* xin, const float* y, const float* lw, const float* lb, float* out, bf16* xn) {
    const int row = blockIdx.x * 4 + (threadIdx.x >> 6), lane = threadIdx.x & 63;
    const float4* xr = (const float4*)(xin + (size_t)row * DM) + lane; const float4* yr = (const float4*)(y + (size_t)row * DM) + lane;
    float4 v[4]; float s = 0.f;
#pragma unroll
    for (int j = 0; j < 4; ++j) { const float4 a = xr[64 * j], b = yr[64 * j]; v[j].x = DN_ALPHA * a.x + b.x; v[j].y = DN_ALPHA * a.y + b.y; v[j].z = DN_ALPHA * a.z + b.z; v[j].w = DN_ALPHA * a.w + b.w; s += (v[j].x + v[j].y) + (v[j].z + v[j].w); }
    const float mean = wave_sum(s) * (1.f / DM); float s2 = 0.f;
#pragma unroll
    for (int j = 0; j < 4; ++j) { v[j].x -= mean; v[j].y -= mean; v[j].z -= mean; v[j].w -= mean; s2 += (v[j].x * v[j].x + v[j].y * v[j].y) + (v[j].z * v[j].z + v[j].w * v[j].w); }
    const float rstd = rsqrtf(wave_sum(s2) * (1.f / DM) + 1e-5f);
    float4* orow = (float4*)(out + (size_t)row * DM) + lane; uint2* xrow = (uint2*)(xn + (size_t)row * DM) + lane;
#pragma unroll
    for (int j = 0; j < 4; ++j) { const float4 w = ((const float4*)lw)[lane + 64 * j], b = ((const float4*)lb)[lane + 64 * j];
        float4 o; o.x = v[j].x * rstd * w.x + b.x; o.y = v[j].y * rstd * w.y + b.y; o.z = v[j].z * rstd * w.z + b.z; o.w = v[j].w * rstd * w.w + b.w;
        orow[64 * j] = o; uint2 p; p.x = f2bf(o.x) | ((unsigned)f2bf(o.y) << 16); p.y = f2bf(o.z) | ((unsigned)f2bf(o.w) << 16); xrow[64 * j] = p; }
}
__global__ void __launch_bounds__(256) k_gla_pre(const bf16* H, const float* a_up, const float* a_bias, float* GA) {
    const int t = blockIdx.x, c = threadIdx.x;
    __shared__ float adn[16];
    if (c < 16) adn[c] = bf2f(H[(size_t)t * NPAD + C_GA + c]);
    __syncthreads();
    float z = a_bias[c];
#pragma unroll
    for (int j = 0; j < 16; ++j) z += adn[j] * a_up[j * 256 + c];
    const float ls = fminf(z, 0.f) - log1pf(expf(-fabsf(z)));
    GA[(size_t)t * 256 + c] = expf(ls * (1.f / 16.f));
}
__global__ void __launch_bounds__(256) k_gla_scan(const bf16* H, const float* GA, float* GO) {
    const int b = blockIdx.x >> 2, hd = blockIdx.x & 3, tid = threadIdx.x, lane = tid & 63, v = (tid >> 6) * 16 + (lane >> 2), kq = lane & 3;
    __shared__ float sq[32][64], sk[32][64], sv[32][64], sa[32][64];
    float s[16];
#pragma unroll
    for (int i = 0; i < 16; ++i) s[i] = 0.f;
    for (int t0 = 0; t0 < SEQ; t0 += 32) {
        __syncthreads();
        for (int i = tid; i < 2048; i += 256) { const int tt = i >> 6, c = i & 63; const size_t row = (size_t)b * SEQ + t0 + tt; const bf16* hr = H + row * NPAD + hd * 64 + c;
            sq[tt][c] = bf2f(hr[C_GQ]) * 0.125f; sk[tt][c] = bf2f(hr[C_GK]); sv[tt][c] = bf2f(hr[C_GV]); sa[tt][c] = GA[row * 256 + hd * 64 + c]; }
        __syncthreads();
        for (int tt = 0; tt < 32; ++tt) {
            const float vv = sv[tt][v]; float o = 0.f;
#pragma unroll
            for (int i = 0; i < 16; ++i) { const int k = kq * 16 + i; s[i] = sa[tt][k] * s[i] + sk[tt][k] * vv; o += sq[tt][k] * s[i]; }
            o += __shfl_xor(o, 1); o += __shfl_xor(o, 2);
            if (kq == 0) GO[((size_t)b * SEQ + t0 + tt) * 256 + hd * 64 + v] = o;
        }
    }
}
__global__ void __launch_bounds__(256) k_gla_post(const bf16* H, const float* GO, const float* norm_w, bf16* O) {
    const int t = blockIdx.x, c = threadIdx.x, lane = c & 63;
    const float o = GO[(size_t)t * 256 + c]; const float ms = wave_sum(o * o) * (1.f / 64.f);
    const float g = bf2f(H[(size_t)t * NPAD + C_GG + c]);
    O[(size_t)t * DM + c] = f2bf(o * rsqrtf(ms + 1e-5f) * norm_w[lane] * silu_f(g));
}
__global__ void __launch_bounds__(256) k_rwkv_pre(const bf16* H, const float* mu, const float* w_up, const float* w0, const float* a_up, const float* a0,
                                                   const float* k_k, const float* k_a, const float* r_k,
                                                   float* RW, bf16* RR, bf16* RK, bf16* RV, bf16* RA, bf16* RB, float* BON) {
    const int t = blockIdx.x, c = threadIdx.x, tl = t & (SEQ - 1);
    const bf16* hr = H + (size_t)t * NPAD + C_R0; const bf16* hp = hr - NPAD; const bool has_prev = tl != 0;
    __shared__ float lo[64];
#define RW_P(j) ([&](int jj) { const float cur = bf2f(hr[jj]); const float prv = has_prev ? bf2f(hp[jj]) : 0.f; return cur + (prv - cur) * mu[jj]; }(j))
    if (c < 32) lo[c] = tanhf(RW_P(1024 + c)); else if (c < 64) lo[c] = RW_P(1024 + c);
    __syncthreads();
    const float r = RW_P(c), k = RW_P(256 + c), v = RW_P(512 + c);
    float d = w0[c], aa = a0[c];
#pragma unroll 8
    for (int j = 0; j < 32; ++j) { d += lo[j] * w_up[j * 256 + c]; aa += lo[32 + j] * a_up[j * 256 + c]; }
    const float a = sigmoid_f(aa), decay = expf(-0.6065306597126334f * sigmoid_f(d));
    float kk = k * k_k[c]; const float n2 = wave_sum(kk * kk); kk = kk / fmaxf(sqrtf(n2), 1e-12f);
    const float k2 = k * (1.f + (a - 1.f) * k_a[c]);
    const float bonus = wave_sum(r * k2 * r_k[c]);
    const size_t o = (size_t)t * 256 + c;
    RW[o] = decay; RR[o] = f2bf(r); RK[o] = f2bf(k2); RV[o] = f2bf(v); RA[o] = f2bf(-kk); RB[o] = f2bf(kk * a);
    if ((c & 63) == 0) BON[(size_t)t * 4 + (c >> 6)] = bonus;
}
__global__ void __launch_bounds__(256) k_rwkv_scan(const float* RW, const bf16* RR, const bf16* RK, const bf16* RV, const bf16* RA, const bf16* RB, float* RY) {
    const int b = blockIdx.x >> 2, hd = blockIdx.x & 3, tid = threadIdx.x, lane = tid & 63, v = (tid >> 6) * 16 + (lane >> 2), kq = lane & 3;
    __shared__ float sr[32][64], sw[32][64], sk[32][64], sv[32][64], sa[32][64], sb[32][64];
    float s[16];
#pragma unroll
    for (int i = 0; i < 16; ++i) s[i] = 0.f;
    for (int t0 = 0; t0 < SEQ; t0 += 32) {
        __syncthreads();
        for (int i = tid; i < 2048; i += 256) { const int tt = i >> 6, c = i & 63; const size_t o = ((size_t)b * SEQ + t0 + tt) * 256 + hd * 64 + c;
            sr[tt][c] = bf2f(RR[o]); sw[tt][c] = RW[o]; sk[tt][c] = bf2f(RK[o]); sv[tt][c] = bf2f(RV[o]); sa[tt][c] = bf2f(RA[o]); sb[tt][c] = bf2f(RB[o]); }
        __syncthreads();
        for (int tt = 0; tt < 32; ++tt) {
            float sA = 0.f;
#pragma unroll
            for (int i = 0; i < 16; ++i) sA += s[i] * sa[tt][kq * 16 + i];
            sA += __shfl_xor(sA, 1); sA += __shfl_xor(sA, 2);
            const float vv = sv[tt][v]; float y = 0.f;
#pragma unroll
            for (int i = 0; i < 16; ++i) { const int k = kq * 16 + i; s[i] = s[i] * sw[tt][k] + sA * sb[tt][k] + vv * sk[tt][k]; y += s[i] * sr[tt][k]; }
            y += __shfl_xor(y, 1); y += __shfl_xor(y, 2);
            if (kq == 0) RY[((size_t)b * SEQ + t0 + tt) * 256 + hd * 64 + v] = y;
        }
    }
}
__global__ void __launch_bounds__(256) k_rwkv_post(const bf16* H, const float* mu, const float* RY, const bf16* RV, const float* BON, const float* gn_w, const float* gn_b, bf16* O) {
    const int t = blockIdx.x, c = threadIdx.x, tl = t & (SEQ - 1);
    const float y = RY[(size_t)t * 256 + c]; const float mean = wave_sum(y) * (1.f / 64.f); const float dl = y - mean; const float var = wave_sum(dl * dl) * (1.f / 64.f);
    float yn = dl * rsqrtf(var + 64e-5f) * gn_w[c] + gn_b[c];
    yn += BON[(size_t)t * 4 + (c >> 6)] * bf2f(RV[(size_t)t * 256 + c]);
    const bf16* hr = H + (size_t)t * NPAD + C_R0 + 768 + c; const float cur = bf2f(hr[0]); const float prv = (tl != 0) ? bf2f(hr[-NPAD]) : 0.f;
    const float g = cur + (prv - cur) * mu[768 + c];
    O[(size_t)t * DM + 768 + c] = f2bf(yn * silu_f(g));
}
__global__ void __launch_bounds__(256) k_moba_kbar(const bf16* H, float* KB) {
    const int bid = blockIdx.x, n = bid & 63, h = (bid >> 6) & 7, b = bid >> 9, tid = threadIdx.x, d = tid & 63, part = tid >> 6;
    __shared__ float red[4][64];
    float s = 0.f;
    for (int tt = 0; tt < 64; ++tt) s += bf2f(H[((size_t)b * SEQ + n * 256 + part * 64 + tt) * NPAD + C_MK + h * 64 + d]);
    red[part][d] = s; __syncthreads();
    if (part == 0) KB[(size_t)bid * 64 + d] = (red[0][d] + red[1][d] + red[2][d] + red[3][d]) * (1.f / 256.f);
}
__device__ __forceinline__ int t5_bucket(int rel) {
    if (rel < 16) return rel;
    const int m = 31 - __clz(rel);
    int bkt = 16 + 2 * (m - 4) + (((unsigned)rel * (unsigned)rel >= (2u << (2 * m))) ? 1 : 0);
    return bkt > 31 ? 31 : bkt;
}
__global__ void __launch_bounds__(256) k_moba_attn(const bf16* H, const float* KB, const float* rel_bias, bf16* O) {
    const int gw = blockIdx.x * 4 + (threadIdx.x >> 6), lane = threadIdx.x & 63;
    const int row = gw >> 3, h = gw & 7, b = row >> 14, tl = row & (SEQ - 1), own = tl >> 8;
    const float NEG = -INFINITY;
    float q[64];
    { const uint4* qp = (const uint4*)(H + (size_t)row * NPAD + C_MQ + h * 64);
#pragma unroll
      for (int i = 0; i < 8; ++i) { const uint4 u = qp[i]; q[8 * i + 0] = __uint_as_float(u.x << 16); q[8 * i + 1] = __uint_as_float(u.x & 0xffff0000u); q[8 * i + 2] = __uint_as_float(u.y << 16); q[8 * i + 3] = __uint_as_float(u.y & 0xffff0000u);
          q[8 * i + 4] = __uint_as_float(u.z << 16); q[8 * i + 5] = __uint_as_float(u.z & 0xffff0000u); q[8 * i + 6] = __uint_as_float(u.w << 16); q[8 * i + 7] = __uint_as_float(u.w & 0xffff0000u); } }
    float gsc = NEG;
    if (lane < own) { const float* kb = KB + ((size_t)(b * 8 + h) * 64 + lane) * 64; float a = 0.f;
#pragma unroll
        for (int d = 0; d < 64; ++d) a += q[d] * kb[d];
        gsc = a; }
    int sel[3]; bool val[3];
#pragma unroll
    for (int r = 0; r < 3; ++r) { const float m = wave_max(gsc); const unsigned long long bal = __ballot(gsc == m); const int idx = __ffsll((long long)bal) - 1; val[r] = (m > NEG); sel[r] = idx; if (lane == idx) gsc = NEG; }
    float s[4][4];
    const bf16* Kb = H + (size_t)b * SEQ * NPAD + C_MK + h * 64; const bf16* Vb = H + (size_t)b * SEQ * NPAD + C_MV + h * 64;
#pragma unroll
    for (int j = 0; j < 4; ++j) {
        const int blk = (j < 3) ? sel[j] : own; const bool valid = (j < 3) ? val[j] : true;
#pragma unroll
        for (int c = 0; c < 4; ++c) {
            float sc = NEG;
            if (valid && (blk * 256 + c * 64 <= tl)) {
                const int kpos = blk * 256 + c * 64 + lane;
                const uint4* kp = (const uint4*)(Kb + (size_t)kpos * NPAD); float a = 0.f;
#pragma unroll
                for (int i = 0; i < 8; ++i) { const uint4 u = kp[i];
                    a += q[8 * i + 0] * __uint_as_float(u.x << 16) + q[8 * i + 1] * __uint_as_float(u.x & 0xffff0000u) + q[8 * i + 2] * __uint_as_float(u.y << 16) + q[8 * i + 3] * __uint_as_float(u.y & 0xffff0000u)
                       + q[8 * i + 4] * __uint_as_float(u.z << 16) + q[8 * i + 5] * __uint_as_float(u.z & 0xffff0000u) + q[8 * i + 6] * __uint_as_float(u.w << 16) + q[8 * i + 7] * __uint_as_float(u.w & 0xffff0000u); }
                const int rel = tl - kpos;
                if (rel >= 0) sc = a * 0.125f + rel_bias[t5_bucket(rel) * 8 + h];
            }
            s[j][c] = sc;
        }
    }
    float mx = NEG;
#pragma unroll
    for (int j = 0; j < 4; ++j)
#pragma unroll
        for (int c = 0; c < 4; ++c) mx = fmaxf(mx, s[j][c]);
    mx = wave_max(mx);
    float sum = 0.f;
#pragma unroll
    for (int j = 0; j < 4; ++j)
#pragma unroll
        for (int c = 0; c < 4; ++c) { s[j][c] = __expf(s[j][c] - mx); sum += s[j][c]; }
    sum = wave_sum(sum);
    float acc = 0.f;
#pragma unroll
    for (int j = 0; j < 4; ++j) {
        const int blk = (j < 3) ? sel[j] : own; const bool valid = (j < 3) ? val[j] : true;
#pragma unroll
        for (int c = 0; c < 4; ++c) {
            if (valid && (blk * 256 + c * 64 <= tl)) {
                const bf16* vp = Vb + (size_t)(blk * 256 + c * 64) * NPAD + lane; const float pj = s[j][c];
                for (int i = 0; i < 64; ++i) acc += __shfl(pj, i) * bf2f(vp[(size_t)i * NPAD]);
            }
        }
    }
    const float g = bf2f(H[(size_t)row * NPAD + C_MG + h * 64 + lane]);
    O[(size_t)row * DM + 256 + h * 64 + lane] = f2bf(acc / sum * silu_f(g));
}
constexpr size_t MiB = (size_t)1 << 20;
constexpr size_t WS_WIN = 2 * MiB, WIN_BYTES = (size_t)NPAD * DM * 2, WS_WOUT = 20 * MiB, WOUT_BYTES = (size_t)DM * DM * 2, WS_KBAR = 24 * MiB, WS_BON = 25 * MiB;
constexpr size_t WS_XN = 32 * MiB, WS_H = 96 * MiB, WS_Y = 368 * MiB, WS_NEED = 512 * MiB;
static_assert(WS_WIN + 2 * WIN_BYTES <= WS_WOUT && WS_WOUT + 2 * WOUT_BYTES <= WS_KBAR && WS_H + (size_t)MTOK * NPAD * 2 <= WS_Y, "ws map");

extern "C" void kernel_launch(void* const* d_in, const int* in_sizes, int n_in, void* d_out, int out_size, void* d_ws, size_t ws_size, hipStream_t stream) {
    static int ready = 0;
    if (!ready) {
        if (n_in != 19 || in_sizes[0] != MTOK * DM || out_size != MTOK * DM || ws_size < WS_NEED) { fprintf(stderr, "kernel_launch: unexpected shapes: n_in %d in0 %d out %d ws %zu\n", n_in, n_in > 0 ? in_sizes[0] : -1, out_size, ws_size); ready = -1; return; }
        if (hipFuncSetAttribute((const void*)k_gemm_in, hipFuncAttributeMaxDynamicSharedMemorySize, GEMM_LDS) != hipSuccess || hipFuncSetAttribute((const void*)k_gemm_out, hipFuncAttributeMaxDynamicSharedMemorySize, GEMM_LDS) != hipSuccess) { fprintf(stderr, "kernel_launch: hipFuncSetAttribute failed\n"); ready = -1; return; }
        ready = 1;
    }
    if (ready < 0) return;
    const float* x = (const float*)d_in[0]; const float* w_in = (const float*)d_in[1]; const float* w_out = (const float*)d_in[2];
    const float* gla_a_up = (const float*)d_in[3]; const float* gla_a_bias = (const float*)d_in[4]; const float* gla_norm_w = (const float*)d_in[5]; const float* rel_bias = (const float*)d_in[6];
    const float* mu = (const float*)d_in[7]; const float* w_up = (const float*)d_in[8]; const float* w0 = (const float*)d_in[9]; const float* a_up = (const float*)d_in[10]; const float* a0 = (const float*)d_in[11];
    const float* k_k = (const float*)d_in[12]; const float* k_a = (const float*)d_in[13]; const float* r_k = (const float*)d_in[14]; const float* gn_w = (const float*)d_in[15]; const float* gn_b = (const float*)d_in[16];
    const float* ln_w = (const float*)d_in[17]; const float* ln_b = (const float*)d_in[18];
    unsigned char* ws = (unsigned char*)d_ws; float* out = (float*)d_out;
    bf16* XN = (bf16*)(ws + WS_XN); bf16* O = XN; bf16* H = (bf16*)(ws + WS_H); float* Y = (float*)(ws + WS_Y); float* KB = (float*)(ws + WS_KBAR); float* BON = (float*)(ws + WS_BON);
    float* GA = (float*)(ws + 368 * MiB); float* GO = (float*)(ws + 400 * MiB);
    float* RW = (float*)(ws + 368 * MiB); bf16* RR = (bf16*)(ws + 400 * MiB); bf16* RK = (bf16*)(ws + 416 * MiB); bf16* RV = (bf16*)(ws + 432 * MiB); bf16* RA = (bf16*)(ws + 448 * MiB); bf16* RB = (bf16*)(ws + 464 * MiB); float* RY = (float*)(ws + 480 * MiB);
    for (int l = 0; l < DEPTH; ++l) {
        k_transpose_w<<<dim3(NPAD / 64, DM / 64), 256, 0, stream>>>(w_in + (size_t)l * DM * D_IN, DM, D_IN, (bf16*)(ws + WS_WIN + l * WIN_BYTES));
        k_transpose_w<<<dim3(DM / 64, DM / 64), 256, 0, stream>>>(w_out + (size_t)l * DM * DM, DM, DM, (bf16*)(ws + WS_WOUT + l * WOUT_BYTES));
    }
    k_cvt_x<<<(unsigned)((size_t)MTOK * DM / 8 / 256), 256, 0, stream>>>(x, XN, (size_t)MTOK * DM / 8);
    for (int l = 0; l < DEPTH; ++l) {
        k_gemm_in<<<256, 512, GEMM_LDS, stream>>>(XN, (const bf16*)(ws + WS_WIN + l * WIN_BYTES), H);
        k_gla_pre<<<MTOK, 256, 0, stream>>>(H, gla_a_up + (size_t)l * 16 * 256, gla_a_bias + (size_t)l * 256, GA);
        k_gla_scan<<<8, 256, 0, stream>>>(H, GA, GO);
        k_gla_post<<<MTOK, 256, 0, stream>>>(H, GO, gla_norm_w + (size_t)l * 64, O);
        k_moba_kbar<<<BATCH * 8 * 64, 256, 0, stream>>>(H, KB);
        k_moba_attn<<<MTOK * 8 / 4, 256, 0, stream>>>(H, KB, rel_bias, O);
        k_rwkv_pre<<<MTOK, 256, 0, stream>>>(H, mu + (size_t)l * 1088, w_up + (size_t)l * 32 * 256, w0 + (size_t)l * 256, a_up + (size_t)l * 32 * 256, a0 + (size_t)l * 256,
                                             k_k + (size_t)l * 256, k_a + (size_t)l * 256, r_k + (size_t)l * 256, RW, RR, RK, RV, RA, RB, BON);
        k_rwkv_scan<<<8, 256, 0, stream>>>(RW, RR, RK, RV, RA, RB, RY);
        k_rwkv_post<<<MTOK, 256, 0, stream>>>(H, mu + (size_t)l * 1088, RY, RV, BON, gn_w + (size_t)l * 256, gn_b + (size_t)l * 256, O);
        k_gemm_out<<<256, 512, GEMM_LDS, stream>>>(O, (const bf16*)(ws + WS_WOUT + l * WOUT_BYTES), Y);
        k_ln<<<MTOK / 4, 256, 0, stream>>>(l == 0 ? x : out, Y, ln_w + (size_t)l * DM, ln_b + (size_t)l * DM, out, XN);
    }
}
```

```cpp
#include <hip/hip_runtime.h>
#include <cstdio>
#include <cstdint>
#include <cmath>
namespace pg8 {
#define PG8_LAS __attribute__((address_space(3)))
typedef unsigned short bf16_t;
typedef short bf16x8 __attribute__((ext_vector_type(8)));
typedef float f32x4 __attribute__((ext_vector_type(4)));
typedef unsigned u32x4 __attribute__((ext_vector_type(4)));
constexpr int BM = 256, BK = 64, HALF = 128, HTB = HALF * BK * 2  , STAGE_BYTES = 8 * HTB, NXCD = 8, WGM = 8;

__host__ __device__ __forceinline__ int lds_byte(int r, int c) { const int st = (r >> 4) * 2 + (c >> 5), rr = r & 15, cc = c & 31, ob = rr * 64 + cc * 2; return st * 1024 + (ob ^ (((ob >> 9) & 1) << 5)); }
__host__ __device__ __forceinline__ void stage_rc(int b, int& R, int& C) { const int st = b / 1024, sb = b % 1024, swz = sb ^ (((sb >> 9) & 1) << 5); R = (st >> 1) * 16 + swz / 64; C = (st & 1) * 32 + (swz % 64) / 2; }
__host__ __device__ __forceinline__ int perm32(int rho) { const int n = rho >> 4, i = rho & 15; return 8 * (i >> 2) + 4 * n + (i & 3); }

struct Unit { int pm, pn; };
struct Gemm { const bf16_t* A; const bf16_t* Bt; int M, N, K; };

struct StaticOrder {
    int nM, nN, nwg, G, c;
    __host__ __device__ void init(int M, int N, int G_, int c_) { nM = M / BM; nN = N / BM; nwg = nM * nN; G = G_; c = c_; }
    __host__ __device__ bool next(int i, Unit& u) const {
        const long L = (long)i * G + c; if (L >= nwg) return false;
        int wgid = (int)L; { const int q = nwg / NXCD, r = nwg % NXCD, xcd = wgid % NXCD, off = wgid / NXCD; wgid = (xcd < r ? xcd * (q + 1) : r * (q + 1) + (xcd - r) * q) + off; }
        const int nig = WGM * nN, gid = wgid / nig, fm = gid * WGM, gsz = (nM - fm) < WGM ? (nM - fm) : WGM;
        u.pm = fm + ((wgid % nig) % gsz); u.pn = (wgid % nig) / gsz; return true;
    }
    __device__ __forceinline__ void a_ready(const Unit&) const {}
    __device__ __forceinline__ void done(const Unit&) const {}
};

__device__ __forceinline__ unsigned cvt_pk_bf16(float lo, float hi) { unsigned r; asm volatile("v_cvt_pk_bf16_f32 %0, %1, %2" : "=v"(r) : "v"(lo), "v"(hi)); return r; }
typedef float f32x2 __attribute__((ext_vector_type(2)));
__device__ __forceinline__ f32x2 gelu_pk(f32x2 v) {
    const f32x2 av = __builtin_elementwise_abs(v), d = av * 0.2316418882f + 1.0f;
    f32x2 t; t.x = __builtin_amdgcn_rcpf(d.x); t.y = __builtin_amdgcn_rcpf(d.y);
    f32x2 q = t * 0.5307027145f + (-0.7265760135f); q = q * t + 0.7107068705f; q = q * t + (-0.142248368f); q = q * t + 0.127414796f; q = q * t;
    const f32x2 s = (v * v) * (-0.72134752044f);
    f32x2 e; e.x = __builtin_amdgcn_exp2f(s.x); e.y = __builtin_amdgcn_exp2f(s.y);
    const f32x2 m = v * (q * e), r = v - m;
    f32x2 o; o.x = v.x < 0.f ? m.x : r.x; o.y = v.y < 0.f ? m.y : r.y; return o;
}

template <int ACT  > struct EpiBf16 {
    static constexpr bool PERM = true, AFTER_DRAIN = false; static_assert(ACT == 0 || ACT == 1, "EpiBf16: ACT is 0 (none) or 1 (gelu_pk)");
    bf16_t* O; int ldc; const float* bias; int split_cols; size_t split_stride; float scale0;
    __device__ __forceinline__ void operator()(const f32x4 (&acc)[2][2][4][2], const Unit& u, int wr, int wc, int fr, int fq) const {
        const int row0 = u.pm * BM + wr * 64 + fr; int colt = u.pn * BM; bf16_t* base = O;
        float sc = 1.f; if (split_cols) { const int t = colt / split_cols; base += (size_t)t * split_stride; colt -= t * split_cols; if (t == 0) sc = scale0; }
        const int col0 = colt + wc * 32 + 8 * fq, bcol0 = u.pn * BM + wc * 32 + 8 * fq;
        f32x4 bv[2][2];
#pragma unroll
        for (int bj = 0; bj < 2; ++bj)
#pragma unroll
            for (int n = 0; n < 2; ++n) bv[bj][n] = bias ? *(const f32x4*)(bias + bcol0 + bj * HALF + 4 * n) : (f32x4){0.f, 0.f, 0.f, 0.f};
#pragma unroll
        for (int ai = 0; ai < 2; ++ai)
#pragma unroll
            for (int m = 0; m < 4; ++m) { bf16_t* rowp = base + (size_t)(row0 + ai * HALF + m * 16) * ldc + col0;
#pragma unroll
                for (int bj = 0; bj < 2; ++bj) { f32x4 v0 = acc[ai][bj][m][0] + bv[bj][0], v1 = acc[ai][bj][m][1] + bv[bj][1];
                    if (ACT == 1) { f32x2 a = gelu_pk((f32x2){v0[0], v0[1]}), b = gelu_pk((f32x2){v0[2], v0[3]}), c = gelu_pk((f32x2){v1[0], v1[1]}), d = gelu_pk((f32x2){v1[2], v1[3]});
                        v0 = (f32x4){a.x, a.y, b.x, b.y}; v1 = (f32x4){c.x, c.y, d.x, d.y}; }
                    v0 = v0 * sc; v1 = v1 * sc; u32x4 w; w.x = cvt_pk_bf16(v0[0], v0[1]); w.y = cvt_pk_bf16(v0[2], v0[3]); w.z = cvt_pk_bf16(v1[0], v1[1]); w.w = cvt_pk_bf16(v1[2], v1[3]);
                    *(u32x4*)(rowp + bj * HALF) = w; } }
    }
};
struct EpiF32 {
    static constexpr bool PERM = false, AFTER_DRAIN = false;
    float* C; int ldc; const float* bias;
    __device__ __forceinline__ void operator()(const f32x4 (&acc)[2][2][4][2], const Unit& u, int wr, int wc, int fr, int fq) const {
        const int row0 = u.pm * BM + wr * 64 + fr, col0 = u.pn * BM + wc * 32 + 4 * fq;
        f32x4 bv[2][2];
#pragma unroll
        for (int bj = 0; bj < 2; ++bj)
#pragma unroll
            for (int n = 0; n < 2; ++n) bv[bj][n] = bias ? *(const f32x4*)(bias + col0 + bj * HALF + n * 16) : (f32x4){0.f, 0.f, 0.f, 0.f};
#pragma unroll
        for (int ai = 0; ai < 2; ++ai)
#pragma unroll
            for (int m = 0; m < 4; ++m) { float* rowp = C + (size_t)(row0 + ai * HALF + m * 16) * ldc + col0;
#pragma unroll
                for (int bj = 0; bj < 2; ++bj)
#pragma unroll
                    for (int n = 0; n < 2; ++n) *(f32x4*)(rowp + bj * HALF + n * 16) = acc[ai][bj][m][n] + bv[bj][n]; }
    }
};
template <class Epi, class Sched, bool ALIGN_EPI = false, bool SP2 = false>
__device__ __forceinline__ void gemm_phase(PG8_LAS unsigned char* lds, const Gemm g, const Sched& S, const Epi& E) {
    int tid_l = threadIdx.x; asm volatile("" : "+v"(tid_l));
    const int tid = tid_l, wid = __builtin_amdgcn_readfirstlane(tid >> 6), lane = tid & 63, wr = wid >> 2, wc = wid & 3, fr = lane & 15, fq = lane >> 4;
    const int K = g.K, nt = K / BK;
    unsigned voffA[2], voffB[2];
#pragma unroll
    for (int i = 0; i < 2; ++i) { int R, C; stage_rc(tid * 16 + i * 8192, R, C); const int Rb = Epi::PERM ? ((R & ~31) + perm32(R & 31)) : R;
        voffA[i] = (unsigned)(R * K + C) * 2u; voffB[i] = (unsigned)(Rb * K + C) * 2u; }
    const size_t kstep = (size_t)(BK * 2);
    const size_t hstep = (size_t)HALF * K * 2;
    const size_t tstep = 2 * hstep;
    const unsigned ldsw = (unsigned)wid * 1024u;
    const int aoff = lds_byte(wr * 64 + fr, fq * 8), boff = lds_byte(wc * 32 + fr, fq * 8);
#define PG8_SA(b, h) (((b) * 2 + (h)) * HTB)
#define PG8_SB(b, h) ((4 + (b) * 2 + (h)) * HTB)
#define PG8_STAGE(bufoff, gbase, voff) do { _Pragma("unroll") for (int _i = 0; _i < 2; ++_i) \
        __builtin_amdgcn_global_load_lds((const unsigned*)((const char*)(gbase) + (voff)[_i]), (PG8_LAS unsigned*)(lds + (bufoff) + ldsw + _i * 8192), 16, 0, 0); } while (0)
#define PG8_LDA(dst, b, h) do { _Pragma("unroll") for (int m = 0; m < 4; ++m) _Pragma("unroll") for (int k = 0; k < 2; ++k) dst[m][k] = *(const PG8_LAS bf16x8*)(lds + PG8_SA(b, h) + aoff + m * 2048 + k * 1024); } while (0)
#define PG8_LDB(dst, b, h) do { _Pragma("unroll") for (int n = 0; n < 2; ++n) _Pragma("unroll") for (int k = 0; k < 2; ++k) dst[n][k] = *(const PG8_LAS bf16x8*)(lds + PG8_SB(b, h) + boff + n * 2048 + k * 1024); } while (0)
#define PG8_MMA(ai, bj, At, Bt) do { __builtin_amdgcn_s_setprio(1); _Pragma("unroll") for (int m = 0; m < 4; ++m) _Pragma("unroll") for (int n = 0; n < 2; ++n) _Pragma("unroll") for (int k = 0; k < 2; ++k) \
        acc[ai][bj][m][n] = __builtin_amdgcn_mfma_f32_16x16x32_bf16(Bt[n][k], At[m][k], acc[ai][bj][m][n], 0, 0, 0); __builtin_amdgcn_s_setprio(0); } while (0)
#define PG8_WAIT_V(n) asm volatile("s_waitcnt vmcnt(" #n ")" ::: "memory")
#define PG8_WAIT_L(n) asm volatile("s_waitcnt lgkmcnt(" #n ")" ::: "memory")
#define PG8_BAR __builtin_amdgcn_s_barrier()
#define PG8_SCHED __builtin_amdgcn_sched_barrier(0)
    Unit cur, nxt; int ui = 0;
    if (!S.next(0, cur)) return;
    f32x4 acc[2][2][4][2];
#pragma unroll
    for (int a = 0; a < 2; ++a)
#pragma unroll
        for (int b = 0; b < 2; ++b)
#pragma unroll
            for (int m = 0; m < 4; ++m)
#pragma unroll
                for (int n = 0; n < 2; ++n) acc[a][b][m][n] = (f32x4){0.f, 0.f, 0.f, 0.f};
    bf16x8 At[4][2], B0[2][2], B1[2][2];
    const char* cA = (const char*)g.A + (size_t)cur.pm * tstep; const char* cB = (const char*)g.Bt + (size_t)cur.pn * tstep;
    S.a_ready(cur);
    if constexpr (SP2) {
        PG8_STAGE(PG8_SB(0, 0), cB, voffB); PG8_STAGE(PG8_SB(0, 1), cB + hstep, voffB); PG8_STAGE(PG8_SA(0, 0), cA, voffA); PG8_STAGE(PG8_SA(0, 1), cA + hstep, voffA);
        if (wr == 1) PG8_BAR;
        PG8_WAIT_V(2); PG8_BAR;
        PG8_STAGE(PG8_SB(1, 0), cB + kstep, voffB); PG8_STAGE(PG8_SA(1, 0), cA + kstep, voffA); PG8_STAGE(PG8_SB(1, 1), cB + hstep + kstep, voffB);
        PG8_WAIT_V(6); PG8_BAR;
    } else {
        PG8_STAGE(PG8_SB(0, 0), cB, voffB); PG8_STAGE(PG8_SA(0, 0), cA, voffA); PG8_STAGE(PG8_SB(0, 1), cB + hstep, voffB); PG8_STAGE(PG8_SA(0, 1), cA + hstep, voffA);
        if (wr == 1) PG8_BAR;
        PG8_WAIT_V(4); PG8_BAR;
        PG8_STAGE(PG8_SB(1, 0), cB + kstep, voffB); PG8_STAGE(PG8_SA(1, 0), cA + kstep, voffA); PG8_STAGE(PG8_SB(1, 1), cB + hstep + kstep, voffB);
        PG8_WAIT_V(6); PG8_BAR;
    }
    for (;;) {
        const bool has_next = S.next(ui + 1, nxt);
        const char* nA = has_next ? (const char*)g.A + (size_t)nxt.pm * tstep : cA; const char* nB = has_next ? (const char*)g.Bt + (size_t)nxt.pn * tstep : cB;
        for (int t = 0; t < nt; t += 2) {
            const bool last = (t == nt - 2);
            const char* a1 = cA + (size_t)(t + 1) * kstep;
            const char* a2 = last ? nA : cA + (size_t)(t + 2) * kstep; const char* b2 = last ? nB : cB + (size_t)(t + 2) * kstep;
            const char* a3 = a2 + kstep; const char* b3 = b2 + kstep;
            if (last && has_next) S.a_ready(nxt);
            if constexpr (SP2) {
            PG8_LDB(B0, 0, 0); PG8_LDB(B1, 0, 1); PG8_SCHED; PG8_LDA(At, 0, 0); PG8_STAGE(PG8_SA(1, 1), a1 + hstep, voffA);
            PG8_WAIT_V(8); PG8_WAIT_L(0); PG8_BAR; PG8_MMA(0, 0, At, B0); PG8_MMA(0, 1, At, B1); PG8_BAR; PG8_SCHED;
            PG8_LDA(At, 0, 1); PG8_STAGE(PG8_SB(0, 0), b2, voffB); PG8_STAGE(PG8_SB(0, 1), b2 + hstep, voffB); PG8_STAGE(PG8_SA(0, 0), a2, voffA);
            PG8_WAIT_V(8); PG8_WAIT_L(0); PG8_BAR; PG8_MMA(1, 0, At, B0); PG8_MMA(1, 1, At, B1); PG8_BAR; PG8_SCHED;
            PG8_LDB(B0, 1, 0); PG8_LDB(B1, 1, 1); PG8_SCHED; PG8_LDA(At, 1, 0); PG8_STAGE(PG8_SA(0, 1), a2 + hstep, voffA);
            PG8_WAIT_V(8); PG8_WAIT_L(0); PG8_BAR; PG8_MMA(0, 0, At, B0); PG8_MMA(0, 1, At, B1); PG8_BAR; PG8_SCHED;
            PG8_LDA(At, 1, 1); PG8_STAGE(PG8_SB(1, 0), b3, voffB); PG8_STAGE(PG8_SB(1, 1), b3 + hstep, voffB); PG8_STAGE(PG8_SA(1, 0), a3, voffA);
            PG8_WAIT_V(8); PG8_WAIT_L(0); PG8_BAR; PG8_MMA(1, 0, At, B0); PG8_MMA(1, 1, At, B1); PG8_BAR; PG8_SCHED;
            } else {
            PG8_LDB(B0, 0, 0); PG8_SCHED; PG8_LDA(At, 0, 0); PG8_STAGE(PG8_SA(1, 1), a1 + hstep, voffA);
            PG8_WAIT_L(8); PG8_BAR; PG8_WAIT_L(0); PG8_MMA(0, 0, At, B0); PG8_BAR; PG8_SCHED;
            PG8_LDB(B1, 0, 1); PG8_STAGE(PG8_SB(0, 0), b2, voffB);
            PG8_BAR; PG8_WAIT_L(0); PG8_MMA(0, 1, At, B1); PG8_BAR;
            PG8_LDA(At, 0, 1); PG8_STAGE(PG8_SA(0, 0), a2, voffA);
            PG8_BAR; PG8_WAIT_L(0); PG8_MMA(1, 0, At, B0); PG8_BAR; PG8_SCHED;
            PG8_STAGE(PG8_SB(0, 1), b2 + hstep, voffB);
            PG8_WAIT_V(6); PG8_BAR; PG8_MMA(1, 1, At, B1); PG8_BAR;
            PG8_LDB(B0, 1, 0); PG8_SCHED; PG8_LDA(At, 1, 0); PG8_STAGE(PG8_SA(0, 1), a2 + hstep, voffA);
            PG8_WAIT_L(8); PG8_BAR; PG8_WAIT_L(0); PG8_MMA(0, 0, At, B0); PG8_BAR; PG8_SCHED;
            PG8_LDB(B1, 1, 1); PG8_STAGE(PG8_SB(1, 0), b3, voffB);
            PG8_BAR; PG8_WAIT_L(0); PG8_MMA(0, 1, At, B1); PG8_BAR;
            PG8_LDA(At, 1, 1); PG8_STAGE(PG8_SA(1, 0), a3, voffA);
            PG8_BAR; PG8_WAIT_L(0); PG8_MMA(1, 0, At, B0); PG8_BAR; PG8_SCHED;
            PG8_STAGE(PG8_SB(1, 1), b3 + hstep, voffB);
            PG8_WAIT_V(6); PG8_BAR; PG8_MMA(1, 1, At, B1); PG8_BAR;
            }
        }
        if constexpr (ALIGN_EPI) { if (wr == 0) PG8_BAR; }
        if constexpr (!Epi::AFTER_DRAIN) { E(acc, cur, wr, wc, fr, fq); S.done(cur); }
        if (!has_next) break;
#pragma unroll
        for (int a = 0; a < 2; ++a)
#pragma unroll
            for (int b = 0; b < 2; ++b)
#pragma unroll
                for (int m = 0; m < 4; ++m)
#pragma unroll
                    for (int n = 0; n < 2; ++n) acc[a][b][m][n] = (f32x4){0.f, 0.f, 0.f, 0.f};
        cur = nxt; cA = nA; cB = nB; ++ui;
        if constexpr (ALIGN_EPI) { if (wr == 1) PG8_BAR; }
    }
    PG8_WAIT_V(0);
    if constexpr (!ALIGN_EPI) { if (wr == 0) PG8_BAR; }
    PG8_BAR;
    if constexpr (Epi::AFTER_DRAIN) { E.fused(acc, cur, wr, wc, fr, fq, lds, wid, lane); S.done(cur); }
#undef PG8_SA
#undef PG8_SB
#undef PG8_STAGE
#undef PG8_LDA
#undef PG8_LDB
#undef PG8_MMA
#undef PG8_WAIT_V
#undef PG8_WAIT_L
#undef PG8_BAR
#undef PG8_SCHED
}
}
#include <hip/hip_cooperative_groups.h>
namespace cg = cooperative_groups;
typedef unsigned short bf16;
#define LAS __attribute__((address_space(3)))
constexpr int BATCH = 2, SEQ = 16384, DM = 1024, DEPTH = 2, MTOK = BATCH * SEQ;
constexpr int D_IN = 4176, NPAD = 4352;
constexpr int C_GQ = 0, C_GK = 256, C_GV = 512, C_GG = 768, C_GA = 1024;
constexpr int C_MQ = 1040, C_MK = 1552, C_MV = 2064, C_MG = 2576;
constexpr int C_R0 = 3088;
constexpr float DN_ALPHA = 1.4142135623730951f;

__device__ __forceinline__ float bf2f(bf16 u) { return __uint_as_float(((unsigned)u) << 16); }
__device__ __forceinline__ bf16 f2bf(float f) { unsigned u = __float_as_uint(f); return (bf16)((u + 0x7fffu + ((u >> 16) & 1u)) >> 16); }
__device__ __forceinline__ float wave_sum(float v) {
#pragma unroll
    for (int o = 1; o < 64; o <<= 1) v += __shfl_xor(v, o);
    return v;
}
__device__ __forceinline__ float wave_max(float v) {
#pragma unroll
    for (int o = 1; o < 64; o <<= 1) v = fmaxf(v, __shfl_xor(v, o));
    return v;
}
__device__ __forceinline__ float silu_f(float g) { return g / (1.f + __expf(-g)); }
__device__ __forceinline__ float sigmoid_f(float z) { return 1.f / (1.f + __expf(-z)); }
__device__ __forceinline__ float tshift(const bf16* H, int row, int col, float mu) {
    const bf16* p = H + (size_t)row * NPAD + col; const float cur = bf2f(p[0]); const float prv = (row & (SEQ - 1)) ? bf2f(p[-NPAD]) : 0.f; return cur + (prv - cur) * mu;
}

constexpr size_t MiB = (size_t)1 << 20;
constexpr size_t WS_WIN = 2 * MiB, WIN_BYTES = (size_t)NPAD * DM * 2, WS_WOUT = 20 * MiB, WOUT_BYTES = (size_t)DM * DM * 2, WS_KBAR = 24 * MiB, WS_BON = 25 * MiB;
constexpr size_t WS_XN = 32 * MiB, WS_H = 96 * MiB, WS_Y = 368 * MiB, WS_NEED = 512 * MiB;
constexpr size_t WS_GO = 368 * MiB, WS_RW = 400 * MiB, WS_RK = 432 * MiB, WS_RA = 448 * MiB, WS_RB = 464 * MiB, WS_RY = 480 * MiB;
static_assert(WS_WIN + 2 * WIN_BYTES <= WS_WOUT && WS_WOUT + 2 * WOUT_BYTES <= WS_KBAR && WS_H + (size_t)MTOK * NPAD * 2 <= WS_Y, "ws map");

extern __shared__ __attribute__((aligned(16))) unsigned char dyn_lds[];
struct Args { const float* in[19]; float* out; unsigned char* ws; };
struct Ctx {
    LAS unsigned char* lds; int tid, vtid, half, vb, nvb;
};
#define HALF_BAR() __syncthreads()
#define MKCTX() Ctx c; { int t_ = threadIdx.x; asm volatile("" : "+v"(t_)); c.lds = (LAS unsigned char*)dyn_lds; c.tid = t_; c.vtid = t_ & 255; c.half = __builtin_amdgcn_readfirstlane(t_ >> 8); c.vb = blockIdx.x * 2 + c.half; c.nvb = gridDim.x * 2; }

__device__ __forceinline__ void ph_transpose_w(const float* W, int K, int N, int Npad, bf16* WT) {
    MKCTX();
    LAS float* tile = (LAS float*)(c.lds + c.half * 65536);
    const int nbx = Npad / 64, nitems = nbx * (K / 64), tid = c.vtid;
    const int iters = (nitems + c.nvb - 1) / c.nvb;
    for (int it = 0; it < iters; ++it) {
        const int item = it * c.nvb + c.vb; const bool act = item < nitems; const int n0 = (item % nbx) * 64, k0 = (item / nbx) * 64;
        HALF_BAR();
        if (act) for (int i = 0; i < 16; ++i) { const int k = i * 4 + (tid >> 6), n = tid & 63; tile[k * 65 + n] = (n0 + n < N) ? W[(size_t)(k0 + k) * N + n0 + n] : 0.f; }
        HALF_BAR();
        if (act) for (int i = 0; i < 16; ++i) { const int n = i * 4 + (tid >> 6), k = tid & 63; WT[(size_t)(n0 + n) * K + k0 + k] = f2bf(tile[k * 65 + n]); }
    }
}
__device__ __forceinline__ void ph_cvt_x(const float* x, bf16* xn) {
    MKCTX();
    const size_t n8 = (size_t)MTOK * DM / 8, stride = (size_t)c.nvb * 256;
    for (size_t i = (size_t)c.vb * 256 + c.vtid; i < n8; i += stride) {
        const float4 a = ((const float4*)x)[2 * i], b = ((const float4*)x)[2 * i + 1];
        uint4 o; o.x = f2bf(a.x) | ((unsigned)f2bf(a.y) << 16); o.y = f2bf(a.z) | ((unsigned)f2bf(a.w) << 16); o.z = f2bf(b.x) | ((unsigned)f2bf(b.y) << 16); o.w = f2bf(b.z) | ((unsigned)f2bf(b.w) << 16);
        ((uint4*)xn)[i] = o;
    }
}
__device__ __forceinline__ void ph_ln(const float* xin, const float* y, const float* lw, const float* lb, float* out, bf16* xn) {
    MKCTX();
    const int lane = c.tid & 63, gw = blockIdx.x * 8 + (c.tid >> 6), ngw = gridDim.x * 8;
    for (int row = gw; row < MTOK; row += ngw) {
        const float4* xr = (const float4*)(xin + (size_t)row * DM) + lane; const float4* yr = (const float4*)(y + (size_t)row * DM) + lane;
        float4 v[4]; float s = 0.f;
#pragma unroll
        for (int j = 0; j < 4; ++j) { const float4 a = xr[64 * j], b = yr[64 * j]; v[j].x = DN_ALPHA * a.x + b.x; v[j].y = DN_ALPHA * a.y + b.y; v[j].z = DN_ALPHA * a.z + b.z; v[j].w = DN_ALPHA * a.w + b.w; s += (v[j].x + v[j].y) + (v[j].z + v[j].w); }
        const float mean = wave_sum(s) * (1.f / DM); float s2 = 0.f;
#pragma unroll
        for (int j = 0; j < 4; ++j) { v[j].x -= mean; v[j].y -= mean; v[j].z -= mean; v[j].w -= mean; s2 += (v[j].x * v[j].x + v[j].y * v[j].y) + (v[j].z * v[j].z + v[j].w * v[j].w); }
        const float rstd = rsqrtf(wave_sum(s2) * (1.f / DM) + 1e-5f);
        float4* orow = (float4*)(out + (size_t)row * DM) + lane; uint2* xrow = (uint2*)(xn + (size_t)row * DM) + lane;
#pragma unroll
        for (int j = 0; j < 4; ++j) { const float4 w = ((const float4*)lw)[lane + 64 * j], b = ((const float4*)lb)[lane + 64 * j];
            float4 o; o.x = v[j].x * rstd * w.x + b.x; o.y = v[j].y * rstd * w.y + b.y; o.z = v[j].z * rstd * w.z + b.z; o.w = v[j].w * rstd * w.w + b.w;
            orow[64 * j] = o; uint2 p; p.x = f2bf(o.x) | ((unsigned)f2bf(o.y) << 16); p.y = f2bf(o.z) | ((unsigned)f2bf(o.w) << 16); xrow[64 * j] = p; }
    }
}
__device__ __forceinline__ void ph_gla_scan(const bf16* H, const float* a_up, const float* a_bias, float* GO) {
    MKCTX(); const int sb = c.vb;
    const int b = sb >> 2, hd = sb & 3, tid = c.vtid, lane = tid & 63, v = (tid >> 6) * 16 + (lane >> 2), kq = lane & 3;
    LAS float* base = (LAS float*)(c.lds + c.half * 65536);
    LAS float* sq = base; LAS float* sk = base + 2048; LAS float* sv = base + 4096; LAS float* sa = base + 6144; LAS float* sdn = base + 8192;
    float s[16];
#pragma unroll
    for (int i = 0; i < 16; ++i) s[i] = 0.f;
    for (int t0 = 0; t0 < SEQ; t0 += 32) {
        HALF_BAR();
        for (int i = tid; i < 512; i += 256) { const int tt = i >> 4, j = i & 15; sdn[i] = bf2f(H[((size_t)b * SEQ + t0 + tt) * NPAD + C_GA + j]); }
        HALF_BAR();
        for (int i = tid; i < 2048; i += 256) { const int tt = i >> 6, ch = i & 63; const size_t row = (size_t)b * SEQ + t0 + tt; const bf16* hr = H + row * NPAD + hd * 64 + ch;
            sq[i] = bf2f(hr[C_GQ]) * 0.125f; sk[i] = bf2f(hr[C_GK]); sv[i] = bf2f(hr[C_GV]);
            float z = a_bias[hd * 64 + ch];
#pragma unroll
            for (int j = 0; j < 16; ++j) z += sdn[tt * 16 + j] * a_up[j * 256 + hd * 64 + ch];
            const float ls = fminf(z, 0.f) - log1pf(expf(-fabsf(z)));
            sa[i] = expf(ls * (1.f / 16.f)); }
        HALF_BAR();
        for (int tt = 0; tt < 32; ++tt) {
            const float vv = sv[tt * 64 + v]; float o = 0.f;
#pragma unroll
            for (int i = 0; i < 16; ++i) { const int k = tt * 64 + kq * 16 + i; s[i] = sa[k] * s[i] + sk[k] * vv; o += sq[k] * s[i]; }
            o += __shfl_xor(o, 1); o += __shfl_xor(o, 2);
            if (kq == 0) GO[((size_t)b * SEQ + t0 + tt) * 256 + hd * 64 + v] = o;
        }
    }
}
__device__ __forceinline__ void ph_gla_post(const bf16* H, const float* GO, const float* norm_w, bf16* O) {
    MKCTX();
    const int ch = c.vtid, lane = ch & 63;
    for (int t = c.vb; t < MTOK; t += c.nvb) {
        const float o = GO[(size_t)t * 256 + ch]; const float ms = wave_sum(o * o) * (1.f / 64.f);
        const float g = bf2f(H[(size_t)t * NPAD + C_GG + ch]);
        O[(size_t)t * DM + ch] = f2bf(o * rsqrtf(ms + 1e-5f) * norm_w[lane] * silu_f(g));
    }
}
__device__ __forceinline__ void ph_rwkv_pre(const bf16* H, const float* mu, const float* w_up, const float* w0, const float* a_up, const float* a0,
                                            const float* k_k, const float* k_a, const float* r_k, float* RW, bf16* RK, bf16* RA, bf16* RB, float* BON) {
    MKCTX();
    const int ch = c.vtid; LAS float* lo = (LAS float*)(c.lds + c.half * 65536);
    const int iters = (MTOK + c.nvb - 1) / c.nvb;
    for (int it = 0; it < iters; ++it) {
        const int t = it * c.nvb + c.vb; const bool act = t < MTOK;
        HALF_BAR();
        if (act) { if (ch < 32) lo[ch] = tanhf(tshift(H, t, C_R0 + 1024 + ch, mu[1024 + ch])); else if (ch < 64) lo[ch] = tshift(H, t, C_R0 + 1024 + ch, mu[1024 + ch]); }
        HALF_BAR();
        if (act) {
            const float r = tshift(H, t, C_R0 + ch, mu[ch]), k = tshift(H, t, C_R0 + 256 + ch, mu[256 + ch]);
            float d = w0[ch], aa = a0[ch];
#pragma unroll 8
            for (int j = 0; j < 32; ++j) { d += lo[j] * w_up[j * 256 + ch]; aa += lo[32 + j] * a_up[j * 256 + ch]; }
            const float a = sigmoid_f(aa), decay = expf(-0.6065306597126334f * sigmoid_f(d));
            float kk = k * k_k[ch]; const float n2 = wave_sum(kk * kk); kk = kk / fmaxf(sqrtf(n2), 1e-12f);
            const float k2 = k * (1.f + (a - 1.f) * k_a[ch]);
            const float bonus = wave_sum(r * k2 * r_k[ch]);
            const size_t o = (size_t)t * 256 + ch;
            RW[o] = decay; RK[o] = f2bf(k2); RA[o] = f2bf(-kk); RB[o] = f2bf(kk * a);
            if ((ch & 63) == 0) BON[(size_t)t * 4 + (ch >> 6)] = bonus;
        }
    }
}
__device__ __forceinline__ void ph_rwkv_scan(const bf16* H, const float* mu, const float* RW, const bf16* RK, const bf16* RA, const bf16* RB, float* RY) {
    MKCTX(); const int sb = c.vb - 8;
    const int b = sb >> 2, hd = sb & 3, tid = c.vtid, lane = tid & 63, v = (tid >> 6) * 16 + (lane >> 2), kq = lane & 3;
    LAS float* base = (LAS float*)(c.lds + c.half * 65536);
    LAS float* sr = base; LAS float* sw = base + 2048; LAS float* sk = base + 4096; LAS float* sv = base + 6144; LAS float* sa = base + 8192; LAS float* sbb = base + 10240;
    float s[16];
#pragma unroll
    for (int i = 0; i < 16; ++i) s[i] = 0.f;
    for (int t0 = 0; t0 < SEQ; t0 += 32) {
        HALF_BAR();
        for (int i = tid; i < 2048; i += 256) { const int tt = i >> 6, ch = i & 63; const int row = b * SEQ + t0 + tt; const size_t o = (size_t)row * 256 + hd * 64 + ch;
            sr[i] = bf2f(f2bf(tshift(H, row, C_R0 + hd * 64 + ch, mu[hd * 64 + ch]))); sv[i] = bf2f(f2bf(tshift(H, row, C_R0 + 512 + hd * 64 + ch, mu[512 + hd * 64 + ch])));
            sw[i] = RW[o]; sk[i] = bf2f(RK[o]); sa[i] = bf2f(RA[o]); sbb[i] = bf2f(RB[o]); }
        HALF_BAR();
        for (int tt = 0; tt < 32; ++tt) {
            float sA = 0.f;
#pragma unroll
            for (int i = 0; i < 16; ++i) sA += s[i] * sa[tt * 64 + kq * 16 + i];
            sA += __shfl_xor(sA, 1); sA += __shfl_xor(sA, 2);
            const float vv = sv[tt * 64 + v]; float y = 0.f;
#pragma unroll
            for (int i = 0; i < 16; ++i) { const int k = tt * 64 + kq * 16 + i; s[i] = s[i] * sw[k] + sA * sbb[k] + vv * sk[k]; y += s[i] * sr[k]; }
            y += __shfl_xor(y, 1); y += __shfl_xor(y, 2);
            if (kq == 0) RY[((size_t)b * SEQ + t0 + tt) * 256 + hd * 64 + v] = y;
        }
    }
}
__device__ __forceinline__ void ph_rwkv_post(const bf16* H, const float* mu, const float* RY, const float* BON, const float* gn_w, const float* gn_b, bf16* O) {
    MKCTX();
    const int ch = c.vtid;
    for (int t = c.vb; t < MTOK; t += c.nvb) {
        const float y = RY[(size_t)t * 256 + ch]; const float mean = wave_sum(y) * (1.f / 64.f); const float dl = y - mean; const float var = wave_sum(dl * dl) * (1.f / 64.f);
        float yn = dl * rsqrtf(var + 64e-5f) * gn_w[ch] + gn_b[ch];
        yn += BON[(size_t)t * 4 + (ch >> 6)] * tshift(H, t, C_R0 + 512 + ch, mu[512 + ch]);
        const float g = tshift(H, t, C_R0 + 768 + ch, mu[768 + ch]);
        O[(size_t)t * DM + 768 + ch] = f2bf(yn * silu_f(g));
    }
}
__device__ __forceinline__ void ph_moba_kbar(const bf16* H, float* KB) {
    MKCTX();
    LAS float* red = (LAS float*)(c.lds + c.half * 65536); const int tid = c.vtid, d = tid & 63, part = tid >> 6;
    const int iters = (BATCH * 8 * 64 + c.nvb - 1) / c.nvb;
    for (int it = 0; it < iters; ++it) {
        const int bid = it * c.nvb + c.vb; const bool act = bid < BATCH * 8 * 64; const int n = bid & 63, h = (bid >> 6) & 7, b = bid >> 9;
        float s = 0.f;
        if (act) for (int tt = 0; tt < 64; ++tt) s += bf2f(H[((size_t)b * SEQ + n * 256 + part * 64 + tt) * NPAD + C_MK + h * 64 + d]);
        HALF_BAR();
        red[part * 64 + d] = s;
        HALF_BAR();
        if (act && part == 0) KB[(size_t)bid * 64 + d] = (red[d] + red[64 + d] + red[128 + d] + red[192 + d]) * (1.f / 256.f);
    }
}
__device__ __forceinline__ int t5_bucket(int rel) {
    if (rel < 16) return rel;
    const int m = 31 - __clz(rel);
    int bkt = 16 + 2 * (m - 4) + (((unsigned)rel * (unsigned)rel >= (2u << (2 * m))) ? 1 : 0);
    return bkt > 31 ? 31 : bkt;
}
__device__ __forceinline__ void moba_query(int row, int h, int lane, const bf16* H, const float* KB, const float* rel_bias, bf16* O) {
    const int b = row >> 14, tl = row & (SEQ - 1), own = tl >> 8;
    const float NEG = -INFINITY;
    float q[64];
    { const uint4* qp = (const uint4*)(H + (size_t)row * NPAD + C_MQ + h * 64);
#pragma unroll
      for (int i = 0; i < 8; ++i) { const uint4 u = qp[i]; q[8 * i + 0] = __uint_as_float(u.x << 16); q[8 * i + 1] = __uint_as_float(u.x & 0xffff0000u); q[8 * i + 2] = __uint_as_float(u.y << 16); q[8 * i + 3] = __uint_as_float(u.y & 0xffff0000u);
          q[8 * i + 4] = __uint_as_float(u.z << 16); q[8 * i + 5] = __uint_as_float(u.z & 0xffff0000u); q[8 * i + 6] = __uint_as_float(u.w << 16); q[8 * i + 7] = __uint_as_float(u.w & 0xffff0000u); } }
    float gsc = NEG;
    if (lane < own) { const float* kb = KB + ((size_t)(b * 8 + h) * 64 + lane) * 64; float a = 0.f;
#pragma unroll
        for (int d = 0; d < 64; ++d) a += q[d] * kb[d];
        gsc = a; }
    int sel[3]; bool val[3];
#pragma unroll
    for (int r = 0; r < 3; ++r) { const float m = wave_max(gsc); const unsigned long long bal = __ballot(gsc == m); const int idx = __ffsll((long long)bal) - 1; val[r] = (m > NEG); sel[r] = idx; if (lane == idx) gsc = NEG; }
    float s[4][4];
    const bf16* Kb = H + (size_t)b * SEQ * NPAD + C_MK + h * 64; const bf16* Vb = H + (size_t)b * SEQ * NPAD + C_MV + h * 64;
#pragma unroll
    for (int j = 0; j < 4; ++j) {
        const int blk = (j < 3) ? sel[j] : own; const bool valid = (j < 3) ? val[j] : true;
#pragma unroll
        for (int cc = 0; cc < 4; ++cc) {
            float sc = NEG;
            if (valid && (blk * 256 + cc * 64 <= tl)) {
                const int kpos = blk * 256 + cc * 64 + lane;
                const uint4* kp = (const uint4*)(Kb + (size_t)kpos * NPAD); float a = 0.f;
#pragma unroll
                for (int i = 0; i < 8; ++i) { const uint4 u = kp[i];
                    a += q[8 * i + 0] * __uint_as_float(u.x << 16) + q[8 * i + 1] * __uint_as_float(u.x & 0xffff0000u) + q[8 * i + 2] * __uint_as_float(u.y << 16) + q[8 * i + 3] * __uint_as_float(u.y & 0xffff0000u)
                       + q[8 * i + 4] * __uint_as_float(u.z << 16) + q[8 * i + 5] * __uint_as_float(u.z & 0xffff0000u) + q[8 * i + 6] * __uint_as_float(u.w << 16) + q[8 * i + 7] * __uint_as_float(u.w & 0xffff0000u); }
                const int rel = tl - kpos;
                if (rel >= 0) sc = a * 0.125f + rel_bias[t5_bucket(rel) * 8 + h];
            }
            s[j][cc] = sc;
        }
    }
    float mx = NEG;
#pragma unroll
    for (int j = 0; j < 4; ++j)
#pragma unroll
        for (int cc = 0; cc < 4; ++cc) mx = fmaxf(mx, s[j][cc]);
    mx = wave_max(mx);
    float sum = 0.f;
#pragma unroll
    for (int j = 0; j < 4; ++j)
#pragma unroll
        for (int cc = 0; cc < 4; ++cc) { s[j][cc] = __expf(s[j][cc] - mx); sum += s[j][cc]; }
    sum = wave_sum(sum);
    float acc = 0.f;
#pragma unroll
    for (int j = 0; j < 4; ++j) {
        const int blk = (j < 3) ? sel[j] : own; const bool valid = (j < 3) ? val[j] : true;
#pragma unroll
        for (int cc = 0; cc < 4; ++cc) {
            if (valid && (blk * 256 + cc * 64 <= tl)) {
                const bf16* vp = Vb + (size_t)(blk * 256 + cc * 64) * NPAD + lane; const float pj = s[j][cc];
                for (int i = 0; i < 64; ++i) acc += __shfl(pj, i) * bf2f(vp[(size_t)i * NPAD]);
            }
        }
    }
    const float g = bf2f(H[(size_t)row * NPAD + C_MG + h * 64 + lane]);
    O[(size_t)row * DM + 256 + h * 64 + lane] = f2bf(acc / sum * silu_f(g));
}
constexpr int LDS_BYTES = 147456;
__global__ void __launch_bounds__(512, 2) mega_fwd(Args args) {
    cg::grid_group grid = cg::this_grid();
#define WSP(T, off) ((T*)(args.ws + (off)))
#define INP(i, off) (args.in[i] + (size_t)(off))
    for (int l = 0; l < DEPTH; ++l) {
        ph_transpose_w(INP(1, (size_t)l * DM * D_IN), DM, D_IN, NPAD, WSP(bf16, WS_WIN + l * WIN_BYTES));
        ph_transpose_w(INP(2, (size_t)l * DM * DM), DM, DM, DM, WSP(bf16, WS_WOUT + l * WOUT_BYTES));
    }
    ph_cvt_x(args.in[0], WSP(bf16, WS_XN));
    grid.sync();
    for (int l = 0; l < DEPTH; ++l) {
        { pg8::Gemm g{WSP(bf16, WS_XN), WSP(const bf16, WS_WIN + l * WIN_BYTES), MTOK, NPAD, DM};
          pg8::StaticOrder S; S.init(MTOK, NPAD, (int)gridDim.x, (int)blockIdx.x);
          pg8::EpiBf16<0> E{WSP(bf16, WS_H), NPAD, nullptr, 0, 0, 1.f};
          pg8::gemm_phase<pg8::EpiBf16<0>, pg8::StaticOrder, true, true>((LAS unsigned char*)dyn_lds, g, S, E); }
        grid.sync();
        ph_rwkv_pre(WSP(bf16, WS_H), INP(7, l * 1088), INP(8, l * 32 * 256), INP(9, l * 256), INP(10, l * 32 * 256), INP(11, l * 256),
                    INP(12, l * 256), INP(13, l * 256), INP(14, l * 256), WSP(float, WS_RW), WSP(bf16, WS_RK), WSP(bf16, WS_RA), WSP(bf16, WS_RB), WSP(float, WS_BON));
        ph_moba_kbar(WSP(bf16, WS_H), WSP(float, WS_KBAR));
        grid.sync();
        if (blockIdx.x < 4) ph_gla_scan( WSP(bf16, WS_H), INP(3, l * 16 * 256), INP(4, l * 256), WSP(float, WS_GO));
        else if (blockIdx.x < 8) ph_rwkv_scan( WSP(bf16, WS_H), INP(7, l * 1088), WSP(float, WS_RW), WSP(bf16, WS_RK), WSP(bf16, WS_RA), WSP(bf16, WS_RB), WSP(float, WS_RY));
        else { MKCTX(); const int lane = c.tid & 63, gw0 = (blockIdx.x - 8) * 8 + (c.tid >> 6), ngw = (gridDim.x - 8) * 8;
               for (int gw = gw0; gw < MTOK * 8; gw += ngw) moba_query(gw >> 3, gw & 7, lane, WSP(bf16, WS_H), WSP(float, WS_KBAR), args.in[6], WSP(bf16, WS_XN)); }
        grid.sync();
        ph_gla_post(WSP(bf16, WS_H), WSP(float, WS_GO), INP(5, l * 64), WSP(bf16, WS_XN));
        ph_rwkv_post(WSP(bf16, WS_H), INP(7, l * 1088), WSP(float, WS_RY), WSP(float, WS_BON), INP(15, l * 256), INP(16, l * 256), WSP(bf16, WS_XN));
        grid.sync();
        { pg8::Gemm g{WSP(bf16, WS_XN), WSP(const bf16, WS_WOUT + l * WOUT_BYTES), MTOK, DM, DM};
          pg8::StaticOrder S; S.init(MTOK, DM, (int)gridDim.x, (int)blockIdx.x);
          pg8::EpiF32 E{WSP(float, WS_Y), DM, nullptr};
          pg8::gemm_phase<pg8::EpiF32, pg8::StaticOrder, true, true>((LAS unsigned char*)dyn_lds, g, S, E); }
        grid.sync();
        ph_ln(l == 0 ? args.in[0] : (const float*)args.out, WSP(float, WS_Y), INP(17, l * DM), INP(18, l * DM), args.out, WSP(bf16, WS_XN));
        if (l + 1 < DEPTH) grid.sync();
    }
}
extern "C" void kernel_launch(void* const* d_in, const int* in_sizes, int n_in, void* d_out, int out_size, void* d_ws, size_t ws_size, hipStream_t stream) {
    static int grid = 0;
    if (grid == 0) {
        if (n_in != 19 || in_sizes[0] != MTOK * DM || out_size != MTOK * DM || ws_size < WS_NEED) { fprintf(stderr, "kernel_launch: unexpected shapes: n_in %d in0 %d out %d ws %zu\n", n_in, n_in > 0 ? in_sizes[0] : -1, out_size, ws_size); grid = -1; return; }
        int dev = 0, cus = 0, per_cu = 0;
        if (hipGetDevice(&dev) != hipSuccess || hipDeviceGetAttribute(&cus, hipDeviceAttributeMultiprocessorCount, dev) != hipSuccess) { fprintf(stderr, "kernel_launch: device query failed\n"); grid = -1; return; }
        if (hipFuncSetAttribute((const void*)mega_fwd, hipFuncAttributeMaxDynamicSharedMemorySize, LDS_BYTES) != hipSuccess) { fprintf(stderr, "kernel_launch: hipFuncSetAttribute failed\n"); grid = -1; return; }
        if (hipOccupancyMaxActiveBlocksPerMultiprocessor(&per_cu, (const void*)mega_fwd, 512, LDS_BYTES) != hipSuccess || per_cu < 1) { fprintf(stderr, "kernel_launch: occupancy query failed (%d)\n", per_cu); grid = -1; return; }
        grid = cus * 1;
        if (grid < 16) { grid = -1; return; }
    }
    if (grid < 0) return;
    Args a{};
    for (int i = 0; i < 19; ++i) a.in[i] = (const float*)d_in[i];
    a.out = (float*)d_out; a.ws = (unsigned char*)d_ws;
    void* kargs[] = {&a};
    hipError_t e = hipLaunchCooperativeKernel((const void*)mega_fwd, dim3(grid), dim3(512), kargs, LDS_BYTES, stream);
    if (e != hipSuccess) fprintf(stderr, "kernel_launch: cooperative launch failed: %s (grid %d)\n", hipGetErrorString(e), grid);
}
```

```cpp
#include <hip/hip_runtime.h>
#include <cstdio>
#include <cstdint>
#include <cmath>
namespace pg8 {
#define PG8_LAS __attribute__((address_space(3)))
typedef unsigned short bf16_t;
typedef short bf16x8 __attribute__((ext_vector_type(8)));
typedef float f32x4 __attribute__((ext_vector_type(4)));
typedef unsigned u32x4 __attribute__((ext_vector_type(4)));
constexpr int BM = 256, BK = 64, HALF = 128, HTB = HALF * BK * 2  , STAGE_BYTES = 8 * HTB, NXCD = 8, WGM = 8;

__host__ __device__ __forceinline__ int lds_byte(int r, int c) { const int st = (r >> 4) * 2 + (c >> 5), rr = r & 15, cc = c & 31, ob = rr * 64 + cc * 2; return st * 1024 + (ob ^ (((ob >> 9) & 1) << 5)); }
__host__ __device__ __forceinline__ void stage_rc(int b, int& R, int& C) { const int st = b / 1024, sb = b % 1024, swz = sb ^ (((sb >> 9) & 1) << 5); R = (st >> 1) * 16 + swz / 64; C = (st & 1) * 32 + (swz % 64) / 2; }
__host__ __device__ __forceinline__ int perm32(int rho) { const int n = rho >> 4, i = rho & 15; return 8 * (i >> 2) + 4 * n + (i & 3); }

struct Unit { int pm, pn; };
struct Gemm { const bf16_t* A; const bf16_t* Bt; int M, N, K; };

struct StaticOrder {
    int nM, nN, nwg, G, c;
    __host__ __device__ void init(int M, int N, int G_, int c_) { nM = M / BM; nN = N / BM; nwg = nM * nN; G = G_; c = c_; }
    __host__ __device__ bool next(int i, Unit& u) const {
        const long L = (long)i * G + c; if (L >= nwg) return false;
        int wgid = (int)L; { const int q = nwg / NXCD, r = nwg % NXCD, xcd = wgid % NXCD, off = wgid / NXCD; wgid = (xcd < r ? xcd * (q + 1) : r * (q + 1) + (xcd - r) * q) + off; }
        const int nig = WGM * nN, gid = wgid / nig, fm = gid * WGM, gsz = (nM - fm) < WGM ? (nM - fm) : WGM;
        u.pm = fm + ((wgid % nig) % gsz); u.pn = (wgid % nig) / gsz; return true;
    }
    __device__ __forceinline__ void a_ready(const Unit&) const {}
    __device__ __forceinline__ void done(const Unit&) const {}
};

__device__ __forceinline__ unsigned cvt_pk_bf16(float lo, float hi) { unsigned r; asm volatile("v_cvt_pk_bf16_f32 %0, %1, %2" : "=v"(r) : "v"(lo), "v"(hi)); return r; }
typedef float f32x2 __attribute__((ext_vector_type(2)));
__device__ __forceinline__ f32x2 gelu_pk(f32x2 v) {
    const f32x2 av = __builtin_elementwise_abs(v), d = av * 0.2316418882f + 1.0f;
    f32x2 t; t.x = __builtin_amdgcn_rcpf(d.x); t.y = __builtin_amdgcn_rcpf(d.y);
    f32x2 q = t * 0.5307027145f + (-0.7265760135f); q = q * t + 0.7107068705f; q = q * t + (-0.142248368f); q = q * t + 0.127414796f; q = q * t;
    const f32x2 s = (v * v) * (-0.72134752044f);
    f32x2 e; e.x = __builtin_amdgcn_exp2f(s.x); e.y = __builtin_amdgcn_exp2f(s.y);
    const f32x2 m = v * (q * e), r = v - m;
    f32x2 o; o.x = v.x < 0.f ? m.x : r.x; o.y = v.y < 0.f ? m.y : r.y; return o;
}

template <int ACT  > struct EpiBf16 {
    static constexpr bool PERM = true, AFTER_DRAIN = false; static_assert(ACT == 0 || ACT == 1, "EpiBf16: ACT is 0 (none) or 1 (gelu_pk)");
    bf16_t* O; int ldc; const float* bias; int split_cols; size_t split_stride; float scale0;
    __device__ __forceinline__ void operator()(const f32x4 (&acc)[2][2][4][2], const Unit& u, int wr, int wc, int fr, int fq) const {
        const int row0 = u.pm * BM + wr * 64 + fr; int colt = u.pn * BM; bf16_t* base = O;
        float sc = 1.f; if (split_cols) { const int t = colt / split_cols; base += (size_t)t * split_stride; colt -= t * split_cols; if (t == 0) sc = scale0; }
        const int col0 = colt + wc * 32 + 8 * fq, bcol0 = u.pn * BM + wc * 32 + 8 * fq;
        f32x4 bv[2][2];
#pragma unroll
        for (int bj = 0; bj < 2; ++bj)
#pragma unroll
            for (int n = 0; n < 2; ++n) bv[bj][n] = bias ? *(const f32x4*)(bias + bcol0 + bj * HALF + 4 * n) : (f32x4){0.f, 0.f, 0.f, 0.f};
#pragma unroll
        for (int ai = 0; ai < 2; ++ai)
#pragma unroll
            for (int m = 0; m < 4; ++m) { bf16_t* rowp = base + (size_t)(row0 + ai * HALF + m * 16) * ldc + col0;
#pragma unroll
                for (int bj = 0; bj < 2; ++bj) { f32x4 v0 = acc[ai][bj][m][0] + bv[bj][0], v1 = acc[ai][bj][m][1] + bv[bj][1];
                    if (ACT == 1) { f32x2 a = gelu_pk((f32x2){v0[0], v0[1]}), b = gelu_pk((f32x2){v0[2], v0[3]}), c = gelu_pk((f32x2){v1[0], v1[1]}), d = gelu_pk((f32x2){v1[2], v1[3]});
                        v0 = (f32x4){a.x, a.y, b.x, b.y}; v1 = (f32x4){c.x, c.y, d.x, d.y}; }
                    v0 = v0 * sc; v1 = v1 * sc; u32x4 w; w.x = cvt_pk_bf16(v0[0], v0[1]); w.y = cvt_pk_bf16(v0[2], v0[3]); w.z = cvt_pk_bf16(v1[0], v1[1]); w.w = cvt_pk_bf16(v1[2], v1[3]);
                    *(u32x4*)(rowp + bj * HALF) = w; } }
    }
};
struct EpiF32 {
    static constexpr bool PERM = false, AFTER_DRAIN = false;
    float* C; int ldc; const float* bias;
    __device__ __forceinline__ void operator()(const f32x4 (&acc)[2][2][4][2], const Unit& u, int wr, int wc, int fr, int fq) const {
        const int row0 = u.pm * BM + wr * 64 + fr, col0 = u.pn * BM + wc * 32 + 4 * fq;
        f32x4 bv[2][2];
#pragma unroll
        for (int bj = 0; bj < 2; ++bj)
#pragma unroll
            for (int n = 0; n < 2; ++n) bv[bj][n] = bias ? *(const f32x4*)(bias + col0 + bj * HALF + n * 16) : (f32x4){0.f, 0.f, 0.f, 0.f};
#pragma unroll
        for (int ai = 0; ai < 2; ++ai)
#pragma unroll
            for (int m = 0; m < 4; ++m) { float* rowp = C + (size_t)(row0 + ai * HALF + m * 16) * ldc + col0;
#pragma unroll
                for (int bj = 0; bj < 2; ++bj)
#pragma unroll
                    for (int n = 0; n < 2; ++n) *(f32x4*)(rowp + bj * HALF + n * 16) = acc[ai][bj][m][n] + bv[bj][n]; }
    }
};
template <class Epi, class Sched, bool ALIGN_EPI = false, bool SP2 = false>
__device__ __forceinline__ void gemm_phase(PG8_LAS unsigned char* lds, const Gemm g, const Sched& S, const Epi& E) {
    int tid_l = threadIdx.x; asm volatile("" : "+v"(tid_l));
    const int tid = tid_l, wid = __builtin_amdgcn_readfirstlane(tid >> 6), lane = tid & 63, wr = wid >> 2, wc = wid & 3, fr = lane & 15, fq = lane >> 4;
    const int K = g.K, nt = K / BK;
    unsigned voffA[2], voffB[2];
#pragma unroll
    for (int i = 0; i < 2; ++i) { int R, C; stage_rc(tid * 16 + i * 8192, R, C); const int Rb = Epi::PERM ? ((R & ~31) + perm32(R & 31)) : R;
        voffA[i] = (unsigned)(R * K + C) * 2u; voffB[i] = (unsigned)(Rb * K + C) * 2u; }
    const size_t kstep = (size_t)(BK * 2);
    const size_t hstep = (size_t)HALF * K * 2;
    const size_t tstep = 2 * hstep;
    const unsigned ldsw = (unsigned)wid * 1024u;
    const int aoff = lds_byte(wr * 64 + fr, fq * 8), boff = lds_byte(wc * 32 + fr, fq * 8);
#define PG8_SA(b, h) (((b) * 2 + (h)) * HTB)
#define PG8_SB(b, h) ((4 + (b) * 2 + (h)) * HTB)
#define PG8_STAGE(bufoff, gbase, voff) do { _Pragma("unroll") for (int _i = 0; _i < 2; ++_i) \
        __builtin_amdgcn_global_load_lds((const unsigned*)((const char*)(gbase) + (voff)[_i]), (PG8_LAS unsigned*)(lds + (bufoff) + ldsw + _i * 8192), 16, 0, 0); } while (0)
#define PG8_LDA(dst, b, h) do { _Pragma("unroll") for (int m = 0; m < 4; ++m) _Pragma("unroll") for (int k = 0; k < 2; ++k) dst[m][k] = *(const PG8_LAS bf16x8*)(lds + PG8_SA(b, h) + aoff + m * 2048 + k * 1024); } while (0)
#define PG8_LDB(dst, b, h) do { _Pragma("unroll") for (int n = 0; n < 2; ++n) _Pragma("unroll") for (int k = 0; k < 2; ++k) dst[n][k] = *(const PG8_LAS bf16x8*)(lds + PG8_SB(b, h) + boff + n * 2048 + k * 1024); } while (0)
#define PG8_MMA(ai, bj, At, Bt) do { __builtin_amdgcn_s_setprio(1); _Pragma("unroll") for (int m = 0; m < 4; ++m) _Pragma("unroll") for (int n = 0; n < 2; ++n) _Pragma("unroll") for (int k = 0; k < 2; ++k) \
        acc[ai][bj][m][n] = __builtin_amdgcn_mfma_f32_16x16x32_bf16(Bt[n][k], At[m][k], acc[ai][bj][m][n], 0, 0, 0); __builtin_amdgcn_s_setprio(0); } while (0)
#define PG8_WAIT_V(n) asm volatile("s_waitcnt vmcnt(" #n ")" ::: "memory")
#define PG8_WAIT_L(n) asm volatile("s_waitcnt lgkmcnt(" #n ")" ::: "memory")
#define PG8_BAR __builtin_amdgcn_s_barrier()
#define PG8_SCHED __builtin_amdgcn_sched_barrier(0)
    Unit cur, nxt; int ui = 0;
    if (!S.next(0, cur)) return;
    f32x4 acc[2][2][4][2];
#pragma unroll
    for (int a = 0; a < 2; ++a)
#pragma unroll
        for (int b = 0; b < 2; ++b)
#pragma unroll
            for (int m = 0; m < 4; ++m)
#pragma unroll
                for (int n = 0; n < 2; ++n) acc[a][b][m][n] = (f32x4){0.f, 0.f, 0.f, 0.f};
    bf16x8 At[4][2], B0[2][2], B1[2][2];
    const char* cA = (const char*)g.A + (size_t)cur.pm * tstep; const char* cB = (const char*)g.Bt + (size_t)cur.pn * tstep;
    S.a_ready(cur);
    if constexpr (SP2) {
        PG8_STAGE(PG8_SB(0, 0), cB, voffB); PG8_STAGE(PG8_SB(0, 1), cB + hstep, voffB); PG8_STAGE(PG8_SA(0, 0), cA, voffA); PG8_STAGE(PG8_SA(0, 1), cA + hstep, voffA);
        if (wr == 1) PG8_BAR;
        PG8_WAIT_V(2); PG8_BAR;
        PG8_STAGE(PG8_SB(1, 0), cB + kstep, voffB); PG8_STAGE(PG8_SA(1, 0), cA + kstep, voffA); PG8_STAGE(PG8_SB(1, 1), cB + hstep + kstep, voffB);
        PG8_WAIT_V(6); PG8_BAR;
    } else {
        PG8_STAGE(PG8_SB(0, 0), cB, voffB); PG8_STAGE(PG8_SA(0, 0), cA, voffA); PG8_STAGE(PG8_SB(0, 1), cB + hstep, voffB); PG8_STAGE(PG8_SA(0, 1), cA + hstep, voffA);
        if (wr == 1) PG8_BAR;
        PG8_WAIT_V(4); PG8_BAR;
        PG8_STAGE(PG8_SB(1, 0), cB + kstep, voffB); PG8_STAGE(PG8_SA(1, 0), cA + kstep, voffA); PG8_STAGE(PG8_SB(1, 1), cB + hstep + kstep, voffB);
        PG8_WAIT_V(6); PG8_BAR;
    }
    for (;;) {
        const bool has_next = S.next(ui + 1, nxt);
        const char* nA = has_next ? (const char*)g.A + (size_t)nxt.pm * tstep : cA; const char* nB = has_next ? (const char*)g.Bt + (size_t)nxt.pn * tstep : cB;
        for (int t = 0; t < nt; t += 2) {
            const bool last = (t == nt - 2);
            const char* a1 = cA + (size_t)(t + 1) * kstep;
            const char* a2 = last ? nA : cA + (size_t)(t + 2) * kstep; const char* b2 = last ? nB : cB + (size_t)(t + 2) * kstep;
            const char* a3 = a2 + kstep; const char* b3 = b2 + kstep;
            if (last && has_next) S.a_ready(nxt);
            if constexpr (SP2) {
            PG8_LDB(B0, 0, 0); PG8_LDB(B1, 0, 1); PG8_SCHED; PG8_LDA(At, 0, 0); PG8_STAGE(PG8_SA(1, 1), a1 + hstep, voffA);
            PG8_WAIT_V(8); PG8_WAIT_L(0); PG8_BAR; PG8_MMA(0, 0, At, B0); PG8_MMA(0, 1, At, B1); PG8_BAR; PG8_SCHED;
            PG8_LDA(At, 0, 1); PG8_STAGE(PG8_SB(0, 0), b2, voffB); PG8_STAGE(PG8_SB(0, 1), b2 + hstep, voffB); PG8_STAGE(PG8_SA(0, 0), a2, voffA);
            PG8_WAIT_V(8); PG8_WAIT_L(0); PG8_BAR; PG8_MMA(1, 0, At, B0); PG8_MMA(1, 1, At, B1); PG8_BAR; PG8_SCHED;
            PG8_LDB(B0, 1, 0); PG8_LDB(B1, 1, 1); PG8_SCHED; PG8_LDA(At, 1, 0); PG8_STAGE(PG8_SA(0, 1), a2 + hstep, voffA);
            PG8_WAIT_V(8); PG8_WAIT_L(0); PG8_BAR; PG8_MMA(0, 0, At, B0); PG8_MMA(0, 1, At, B1); PG8_BAR; PG8_SCHED;
            PG8_LDA(At, 1, 1); PG8_STAGE(PG8_SB(1, 0), b3, voffB); PG8_STAGE(PG8_SB(1, 1), b3 + hstep, voffB); PG8_STAGE(PG8_SA(1, 0), a3, voffA);
            PG8_WAIT_V(8); PG8_WAIT_L(0); PG8_BAR; PG8_MMA(1, 0, At, B0); PG8_MMA(1, 1, At, B1); PG8_BAR; PG8_SCHED;
            } else {
            PG8_LDB(B0, 0, 0); PG8_SCHED; PG8_LDA(At, 0, 0); PG8_STAGE(PG8_SA(1, 1), a1 + hstep, voffA);
            PG8_WAIT_L(8); PG8_BAR; PG8_WAIT_L(0); PG8_MMA(0, 0, At, B0); PG8_BAR; PG8_SCHED;
            PG8_LDB(B1, 0, 1); PG8_STAGE(PG8_SB(0, 0), b2, voffB);
            PG8_BAR; PG8_WAIT_L(0); PG8_MMA(0, 1, At, B1); PG8_BAR;
            PG8_LDA(At, 0, 1); PG8_STAGE(PG8_SA(0, 0), a2, voffA);
            PG8_BAR; PG8_WAIT_L(0); PG8_MMA(1, 0, At, B0); PG8_BAR; PG8_SCHED;
            PG8_STAGE(PG8_SB(0, 1), b2 + hstep, voffB);
            PG8_WAIT_V(6); PG8_BAR; PG8_MMA(1, 1, At, B1); PG8_BAR;
            PG8_LDB(B0, 1, 0); PG8_SCHED; PG8_LDA(At, 1, 0); PG8_STAGE(PG8_SA(0, 1), a2 + hstep, voffA);
            PG8_WAIT_L(8); PG8_BAR; PG8_WAIT_L(0); PG8_MMA(0, 0, At, B0); PG8_BAR; PG8_SCHED;
            PG8_LDB(B1, 1, 1); PG8_STAGE(PG8_SB(1, 0), b3, voffB);
            PG8_BAR; PG8_WAIT_L(0); PG8_MMA(0, 1, At, B1); PG8_BAR;
            PG8_LDA(At, 1, 1); PG8_STAGE(PG8_SA(1, 0), a3, voffA);
            PG8_BAR; PG8_WAIT_L(0); PG8_MMA(1, 0, At, B0); PG8_BAR; PG8_SCHED;
            PG8_STAGE(PG8_SB(1, 1), b3 + hstep, voffB);
            PG8_WAIT_V(6); PG8_BAR; PG8_MMA(1, 1, At, B1); PG8_BAR;
            }
        }
        if constexpr (ALIGN_EPI) { if (wr == 0) PG8_BAR; }
        if constexpr (!Epi::AFTER_DRAIN) { E(acc, cur, wr, wc, fr, fq); S.done(cur); }
        if (!has_next) break;
#pragma unroll
        for (int a = 0; a < 2; ++a)
#pragma unroll
            for (int b = 0; b < 2; ++b)
#pragma unroll
                for (int m = 0; m < 4; ++m)
#pragma unroll
                    for (int n = 0; n < 2; ++n) acc[a][b][m][n] = (f32x4){0.f, 0.f, 0.f, 0.f};
        cur = nxt; cA = nA; cB = nB; ++ui;
        if constexpr (ALIGN_EPI) { if (wr == 1) PG8_BAR; }
    }
    PG8_WAIT_V(0);
    if constexpr (!ALIGN_EPI) { if (wr == 0) PG8_BAR; }
    PG8_BAR;
    if constexpr (Epi::AFTER_DRAIN) { E.fused(acc, cur, wr, wc, fr, fq, lds, wid, lane); S.done(cur); }
#undef PG8_SA
#undef PG8_SB
#undef PG8_STAGE
#undef PG8_LDA
#undef PG8_LDB
#undef PG8_MMA
#undef PG8_WAIT_V
#undef PG8_WAIT_L
#undef PG8_BAR
#undef PG8_SCHED
}
}
#include <hip/hip_cooperative_groups.h>
namespace cg = cooperative_groups;
typedef unsigned short bf16;
#define LAS __attribute__((address_space(3)))
constexpr int BATCH = 2, SEQ = 16384, DM = 1024, DEPTH = 2, MTOK = BATCH * SEQ;
constexpr int D_IN = 4176, NPAD = 4352;
constexpr int C_GQ = 0, C_GK = 256, C_GV = 512, C_GG = 768, C_GA = 1024;
constexpr int C_MQ = 1040, C_MK = 1552, C_MV = 2064, C_MG = 2576;
constexpr int C_R0 = 3088;
constexpr float DN_ALPHA = 1.4142135623730951f;

__device__ __forceinline__ float bf2f(bf16 u) { return __uint_as_float(((unsigned)u) << 16); }
__device__ __forceinline__ bf16 f2bf(float f) { unsigned u = __float_as_uint(f); return (bf16)((u + 0x7fffu + ((u >> 16) & 1u)) >> 16); }
__device__ __forceinline__ float wave_sum(float v) {
#pragma unroll
    for (int o = 1; o < 64; o <<= 1) v += __shfl_xor(v, o);
    return v;
}
__device__ __forceinline__ float wave_max(float v) {
#pragma unroll
    for (int o = 1; o < 64; o <<= 1) v = fmaxf(v, __shfl_xor(v, o));
    return v;
}
__device__ __forceinline__ float silu_f(float g) { return g / (1.f + __expf(-g)); }
__device__ __forceinline__ float sigmoid_f(float z) { return 1.f / (1.f + __expf(-z)); }
__device__ __forceinline__ unsigned pk_bf16(float lo, float hi) { return (unsigned)f2bf(lo) | ((unsigned)f2bf(hi) << 16); }
__device__ __forceinline__ float bflo(unsigned u) { return __uint_as_float(u << 16); }
__device__ __forceinline__ float bfhi(unsigned u) { return __uint_as_float(u & 0xffff0000u); }
__device__ __forceinline__ float tshift(const bf16* H, int row, int col, float mu) {
    const bf16* p = H + (size_t)row * NPAD + col; const float cur = bf2f(p[0]); const float prv = (row & (SEQ - 1)) ? bf2f(p[-NPAD]) : 0.f; return cur + (prv - cur) * mu;
}

constexpr size_t MiB = (size_t)1 << 20;
constexpr size_t WS_CNT = 1 * MiB, WS_WIN = 2 * MiB, WIN_BYTES = (size_t)NPAD * DM * 2, WS_WOUT = 20 * MiB, WOUT_BYTES = (size_t)DM * DM * 2, WS_KBH = 24 * MiB, WS_KBL = 24 * MiB + 512 * 1024, WS_BON = 25 * MiB, WS_GD = 26 * MiB, WS_GC = 27 * MiB;
constexpr size_t WS_XN = 32 * MiB, WS_H = 96 * MiB, WS_Y = 96 * MiB, WS_O = 368 * MiB, WS_GU = 368 * MiB, WS_GGP = 384 * MiB, WS_GHC = 400 * MiB, WS_LIST = 416 * MiB;
constexpr size_t WS_GS = 432 * MiB, WS_GQ = 448 * MiB, WS_GYL = 464 * MiB, WS_GS2 = 480 * MiB, WS_NEED = 512 * MiB;
constexpr size_t WS_SEL = 28 * MiB, WS_KBF = 29 * MiB, WS_ERR = 0;
constexpr size_t DO_PART = 0, DO_ML = 96 * MiB;
static_assert(WS_WIN + 2 * WIN_BYTES <= WS_WOUT && WS_WOUT + 2 * WOUT_BYTES <= WS_KBH && WS_H + (size_t)MTOK * NPAD * 2 <= WS_O && 16 * (size_t)516096 * 2 <= 16 * MiB, "ws map");
extern __shared__ __attribute__((aligned(16))) unsigned char dyn_lds[];
struct Args { const float* in[19]; float* out; unsigned char* ws; };
struct Ctx {
    LAS unsigned char* lds; int tid, vtid, half, vb, nvb;
};
#define HALF_BAR() __syncthreads()
#define MKCTX() Ctx c; { int t_ = threadIdx.x; asm volatile("" : "+v"(t_)); c.lds = (LAS unsigned char*)dyn_lds; c.tid = t_; c.vtid = t_ & 255; c.half = __builtin_amdgcn_readfirstlane(t_ >> 8); c.vb = blockIdx.x * 2 + c.half; c.nvb = gridDim.x * 2; }

__device__ __forceinline__ void ph_transpose_w(const float* W, int K, int N, int Npad, bf16* WT) {
    MKCTX();
    LAS float* tile = (LAS float*)(c.lds + c.half * 65536);
    const int nbx = Npad / 64, nitems = nbx * (K / 64), tid = c.vtid;
    const int iters = (nitems + c.nvb - 1) / c.nvb;
    for (int it = 0; it < iters; ++it) {
        const int item = it * c.nvb + c.vb; const bool act = item < nitems; const int n0 = (item % nbx) * 64, k0 = (item / nbx) * 64;
        HALF_BAR();
        if (act) for (int i = 0; i < 16; ++i) { const int k = i * 4 + (tid >> 6), n = tid & 63; tile[k * 65 + n] = (n0 + n < N) ? W[(size_t)(k0 + k) * N + n0 + n] : 0.f; }
        HALF_BAR();
        if (act) for (int i = 0; i < 16; ++i) { const int n = i * 4 + (tid >> 6), k = tid & 63; WT[(size_t)(n0 + n) * K + k0 + k] = f2bf(tile[k * 65 + n]); }
    }
}
__device__ __forceinline__ void ph_cvt_x(const float* x, bf16* xn) {
    MKCTX();
    const size_t n8 = (size_t)MTOK * DM / 8, stride = (size_t)c.nvb * 256;
    for (size_t i = (size_t)c.vb * 256 + c.vtid; i < n8; i += stride) {
        const float4 a = ((const float4*)x)[2 * i], b = ((const float4*)x)[2 * i + 1];
        uint4 o; o.x = f2bf(a.x) | ((unsigned)f2bf(a.y) << 16); o.y = f2bf(a.z) | ((unsigned)f2bf(a.w) << 16); o.z = f2bf(b.x) | ((unsigned)f2bf(b.y) << 16); o.w = f2bf(b.z) | ((unsigned)f2bf(b.w) << 16);
        ((uint4*)xn)[i] = o;
    }
}
template <bool LAST> __device__ __forceinline__ void ph_ln(const float* xin, bf16* xn, const float* y, const float* lw, const float* lb, float* out) {
    MKCTX();
    const int lane = c.tid & 63, gw = blockIdx.x * 8 + (c.tid >> 6), ngw = gridDim.x * 8;
    for (int row = gw; row < MTOK; row += ngw) {
        const float4* yr = (const float4*)(y + (size_t)row * DM) + lane;
        float4 v[4]; float s = 0.f;
#pragma unroll
        for (int j = 0; j < 4; ++j) { float4 a;
            if (LAST) { const uint2 u = ((const uint2*)(xn + (size_t)row * DM))[lane + 64 * j]; a.x = bflo(u.x); a.y = bfhi(u.x); a.z = bflo(u.y); a.w = bfhi(u.y); }
            else a = ((const float4*)(xin + (size_t)row * DM))[lane + 64 * j];
            const float4 b = yr[64 * j]; v[j].x = DN_ALPHA * a.x + b.x; v[j].y = DN_ALPHA * a.y + b.y; v[j].z = DN_ALPHA * a.z + b.z; v[j].w = DN_ALPHA * a.w + b.w; s += (v[j].x + v[j].y) + (v[j].z + v[j].w); }
        const float mean = wave_sum(s) * (1.f / DM); float s2 = 0.f;
#pragma unroll
        for (int j = 0; j < 4; ++j) { v[j].x -= mean; v[j].y -= mean; v[j].z -= mean; v[j].w -= mean; s2 += (v[j].x * v[j].x + v[j].y * v[j].y) + (v[j].z * v[j].z + v[j].w * v[j].w); }
        const float rstd = rsqrtf(wave_sum(s2) * (1.f / DM) + 1e-5f);
#pragma unroll
        for (int j = 0; j < 4; ++j) { const float4 w = ((const float4*)lw)[lane + 64 * j], b = ((const float4*)lb)[lane + 64 * j];
            float4 o; o.x = v[j].x * rstd * w.x + b.x; o.y = v[j].y * rstd * w.y + b.y; o.z = v[j].z * rstd * w.z + b.z; o.w = v[j].w * rstd * w.w + b.w;
            if (LAST) ((float4*)(out + (size_t)row * DM))[lane + 64 * j] = o;
            else { uint2 p; p.x = pk_bf16(o.x, o.y); p.y = pk_bf16(o.z, o.w); ((uint2*)(xn + (size_t)row * DM))[lane + 64 * j] = p; } }
    }
}
__device__ __forceinline__ void ph_gla_scan(const bf16* H, const float* a_up, const float* a_bias, float* GO) {
    MKCTX(); const int sb = c.vb;
    const int b = sb >> 2, hd = sb & 3, tid = c.vtid, lane = tid & 63, v = (tid >> 6) * 16 + (lane >> 2), kq = lane & 3;
    LAS float* base = (LAS float*)(c.lds + c.half * 65536);
    LAS float* sq = base; LAS float* sk = base + 2048; LAS float* sv = base + 4096; LAS float* sa = base + 6144; LAS float* sdn = base + 8192;
    float s[16];
#pragma unroll
    for (int i = 0; i < 16; ++i) s[i] = 0.f;
    for (int t0 = 0; t0 < SEQ; t0 += 32) {
        HALF_BAR();
        for (int i = tid; i < 512; i += 256) { const int tt = i >> 4, j = i & 15; sdn[i] = bf2f(H[((size_t)b * SEQ + t0 + tt) * NPAD + C_GA + j]); }
        HALF_BAR();
        for (int i = tid; i < 2048; i += 256) { const int tt = i >> 6, ch = i & 63; const size_t row = (size_t)b * SEQ + t0 + tt; const bf16* hr = H + row * NPAD + hd * 64 + ch;
            sq[i] = bf2f(hr[C_GQ]) * 0.125f; sk[i] = bf2f(hr[C_GK]); sv[i] = bf2f(hr[C_GV]);
            float z = a_bias[hd * 64 + ch];
#pragma unroll
            for (int j = 0; j < 16; ++j) z += sdn[tt * 16 + j] * a_up[j * 256 + hd * 64 + ch];
            const float ls = fminf(z, 0.f) - log1pf(expf(-fabsf(z)));
            sa[i] = expf(ls * (1.f / 16.f)); }
        HALF_BAR();
        for (int tt = 0; tt < 32; ++tt) {
            const float vv = sv[tt * 64 + v]; float o = 0.f;
#pragma unroll
            for (int i = 0; i < 16; ++i) { const int k = tt * 64 + kq * 16 + i; s[i] = sa[k] * s[i] + sk[k] * vv; o += sq[k] * s[i]; }
            o += __shfl_xor(o, 1); o += __shfl_xor(o, 2);
            if (kq == 0) GO[((size_t)b * SEQ + t0 + tt) * 256 + hd * 64 + v] = o;
        }
    }
}
__device__ __forceinline__ void ph_gla_post(const bf16* H, const float* GO, const float* norm_w, bf16* O) {
    MKCTX();
    const int ch = c.vtid, lane = ch & 63;
    for (int t = c.vb; t < MTOK; t += c.nvb) {
        const float o = GO[(size_t)t * 256 + ch]; const float ms = wave_sum(o * o) * (1.f / 64.f);
        const float g = bf2f(H[(size_t)t * NPAD + C_GG + ch]);
        O[(size_t)t * DM + ch] = f2bf(o * rsqrtf(ms + 1e-5f) * norm_w[lane] * silu_f(g));
    }
}

typedef short bf16x8 __attribute__((ext_vector_type(8)));
typedef float f32x4 __attribute__((ext_vector_type(4)));
typedef unsigned u32x4 __attribute__((ext_vector_type(4)));
constexpr int HLD = NPAD;
constexpr int TP = 72, TILE_B = 64 * TP * 2;
constexpr int TEAM_LDS = 73728;
struct Team { LAS unsigned char* lds; int ttid, tw, lane, fr, g, team, gteam, nteams; };
#define MKTEAM() Team T; { int t_ = threadIdx.x; asm volatile("" : "+v"(t_)); T.team = __builtin_amdgcn_readfirstlane(t_ >> 8); T.lds = (LAS unsigned char*)dyn_lds + T.team * TEAM_LDS; T.ttid = t_ & 255; \
    T.tw = __builtin_amdgcn_readfirstlane((t_ >> 6) & 3); T.lane = t_ & 63; T.fr = T.lane & 15; T.g = T.lane >> 4; T.gteam = blockIdx.x * 2 + T.team; T.nteams = gridDim.x * 2; }
__device__ __forceinline__ void mm_row4(f32x4 (&acc)[4], const LAS bf16* A, const LAS bf16* Bt, int mt, int fr, int g) {
#pragma unroll
    for (int ks = 0; ks < 2; ++ks) {
        const bf16x8 a = *(const LAS bf16x8*)(A + (mt * 16 + fr) * TP + ks * 32 + g * 8);
#pragma unroll
        for (int n = 0; n < 4; ++n) { const bf16x8 b = *(const LAS bf16x8*)(Bt + (n * 16 + fr) * TP + ks * 32 + g * 8); acc[n] = __builtin_amdgcn_mfma_f32_16x16x32_bf16(a, b, acc[n], 0, 0, 0); }
    }
}
__device__ __forceinline__ void gla_cum(const Team& T, const bf16* H, size_t row0, int hd, const float* a_up, const float* a_bias, LAS float* adn, LAS float* cum) {
    { const int s = T.ttid >> 2, j0 = (T.ttid & 3) * 4; const uint2 u = *(const uint2*)(H + (row0 + s) * HLD + C_GA + j0);
      adn[s * 16 + j0 + 0] = bflo(u.x); adn[s * 16 + j0 + 1] = bfhi(u.x); adn[s * 16 + j0 + 2] = bflo(u.y); adn[s * 16 + j0 + 3] = bfhi(u.y); }
    const int k = T.ttid & 63; float au[16];
#pragma unroll
    for (int j = 0; j < 16; ++j) au[j] = a_up[j * 256 + hd * 64 + k];
    const float bias = a_bias[hd * 64 + k];
    __syncthreads();
#pragma unroll 4
    for (int i = 0; i < 16; ++i) { const int t = T.tw + 4 * i; float z = bias;
#pragma unroll
        for (int j = 0; j < 16; ++j) z += adn[t * 16 + j] * au[j];
        cum[t * 64 + k] = (fminf(z, 0.f) - log1pf(__expf(-fabsf(z)))) * (1.f / 16.f); }
    __syncthreads();
    if (T.ttid < 64) { float a = 0.f;
#pragma unroll 8
        for (int t = 0; t < 64; ++t) { a += cum[t * 64 + T.ttid]; cum[t * 64 + T.ttid] = a; } }
    __syncthreads();
}
#define UNPK16(dst, a, b) do { dst[0] = bflo(a.x); dst[1] = bfhi(a.x); dst[2] = bflo(a.y); dst[3] = bfhi(a.y); dst[4] = bflo(a.z); dst[5] = bfhi(a.z); dst[6] = bflo(a.w); dst[7] = bfhi(a.w); \
    dst[8] = bflo(b.x); dst[9] = bfhi(b.x); dst[10] = bflo(b.y); dst[11] = bfhi(b.y); dst[12] = bflo(b.z); dst[13] = bfhi(b.z); dst[14] = bflo(b.w); dst[15] = bfhi(b.w); } while (0)
__device__ __forceinline__ void gla_b_item(const Team& T, int ci, const bf16* H, const float* a_up, const float* a_bias, bf16* GU, float* GD) {
    const int c = ci & 255, hd = (ci >> 8) & 3, b = ci >> 10; const size_t row0 = (size_t)b * SEQ + c * 64;
    LAS float* adn = (LAS float*)T.lds; LAS float* cum = (LAS float*)(T.lds + 4096); LAS bf16* VT = (LAS bf16*)(T.lds + 20480); LAS bf16* KT = (LAS bf16*)(T.lds + 20480 + TILE_B);
    const int s = T.ttid >> 2, c0 = (T.ttid & 3) * 16;
    const bf16* hrow = H + (row0 + s) * HLD + hd * 64 + c0;
    const uint4 v0 = *(const uint4*)(hrow + C_GV), v1 = *(const uint4*)(hrow + C_GV + 8), k0 = *(const uint4*)(hrow + C_GK), k1 = *(const uint4*)(hrow + C_GK + 8);
    gla_cum(T, H, row0, hd, a_up, a_bias, adn, cum);
    { float vv[16], kk[16]; UNPK16(vv, v0, v1); UNPK16(kk, k0, k1);
#pragma unroll
      for (int i = 0; i < 16; ++i) { VT[(c0 + i) * TP + s] = f2bf(vv[i]); KT[(c0 + i) * TP + s] = f2bf(kk[i] * __expf(cum[63 * 64 + c0 + i] - cum[s * 64 + c0 + i])); } }
    if (T.ttid < 64) GD[(size_t)ci * 64 + T.ttid] = __expf(cum[63 * 64 + T.ttid]);
    __syncthreads();
    f32x4 acc[4];
#pragma unroll
    for (int n = 0; n < 4; ++n) acc[n] = (f32x4){0.f, 0.f, 0.f, 0.f};
    mm_row4(acc, VT, KT, T.tw, T.fr, T.g);
#pragma unroll
    for (int n = 0; n < 4; ++n)
#pragma unroll
        for (int r = 0; r < 4; ++r) GU[(size_t)ci * 4096 + (16 * T.tw + 4 * T.g + r) * 64 + n * 16 + T.fr] = f2bf(acc[n][r]);
    __syncthreads();
}
__device__ __forceinline__ void ph_gla_b(const bf16* H, const float* a_up, const float* a_bias, bf16* GU, float* GD) {
    MKTEAM();
    for (int ci = T.gteam; ci < 2048; ci += T.nteams) gla_b_item(T, ci, H, a_up, a_bias, GU, GD);
}
__device__ __forceinline__ void ph_gla_scan_fast(const bf16* GU, const float* GD, bf16* GS) {
    int tid = threadIdx.x; asm volatile("" : "+v"(tid));
    const int sb = blockIdx.x, e0 = tid * 8, k0 = e0 & 63;
    float S[8];
#pragma unroll
    for (int i = 0; i < 8; ++i) S[i] = 0.f;
    const bf16* up = GU + (size_t)sb * 256 * 4096 + e0; const float* dp = GD + (size_t)sb * 256 * 64 + k0; bf16* sp = GS + (size_t)sb * 256 * 4096 + e0;
    uint4 u = *(const uint4*)up; float4 d0 = ((const float4*)dp)[0], d1 = ((const float4*)dp)[1];
    for (int c = 0; c < 256; ++c) {
        uint4 nu = u; float4 nd0 = d0, nd1 = d1;
        if (c + 1 < 256) { nu = *(const uint4*)(up + (size_t)(c + 1) * 4096); nd0 = ((const float4*)(dp + (c + 1) * 64))[0]; nd1 = ((const float4*)(dp + (c + 1) * 64))[1]; }
        uint4 o; o.x = pk_bf16(S[0], S[1]); o.y = pk_bf16(S[2], S[3]); o.z = pk_bf16(S[4], S[5]); o.w = pk_bf16(S[6], S[7]);
        *(uint4*)(sp + (size_t)c * 4096) = o;
        S[0] = d0.x * S[0] + bflo(u.x); S[1] = d0.y * S[1] + bfhi(u.x); S[2] = d0.z * S[2] + bflo(u.y); S[3] = d0.w * S[3] + bfhi(u.y);
        S[4] = d1.x * S[4] + bflo(u.z); S[5] = d1.y * S[5] + bfhi(u.z); S[6] = d1.z * S[6] + bflo(u.w); S[7] = d1.w * S[7] + bfhi(u.w);
        u = nu; d0 = nd0; d1 = nd1;
    }
}
__device__ __forceinline__ void gla_d_item(const Team& T, int ci, const bf16* H, const float* a_up, const float* a_bias, const bf16* GS, const float* norm_w, bf16* O) {
    const int c = ci & 255, hd = (ci >> 8) & 3, b = ci >> 10; const size_t row0 = (size_t)b * SEQ + c * 64;
    LAS float* adn = (LAS float*)T.lds; LAS float* cum = (LAS float*)(T.lds + 4096);
    LAS bf16* QT = (LAS bf16*)(T.lds + 20480); LAS bf16* KT = QT + 64 * TP; LAS bf16* VT = KT + 64 * TP; LAS bf16* ST = VT + 64 * TP; LAS bf16* PT = ST + 64 * TP;
    const int s = T.ttid >> 2, c0 = (T.ttid & 3) * 16;
    const bf16* hrow = H + (row0 + s) * HLD + hd * 64 + c0;
    const uint4 q0 = *(const uint4*)(hrow + C_GQ), q1 = *(const uint4*)(hrow + C_GQ + 8), k0 = *(const uint4*)(hrow + C_GK), k1 = *(const uint4*)(hrow + C_GK + 8);
    const uint4 v0 = *(const uint4*)(hrow + C_GV), v1 = *(const uint4*)(hrow + C_GV + 8);
    const uint4 s0 = *(const uint4*)(GS + (size_t)ci * 4096 + s * 64 + c0), s1 = *(const uint4*)(GS + (size_t)ci * 4096 + s * 64 + c0 + 8);
    gla_cum(T, H, row0, hd, a_up, a_bias, adn, cum);
    { float vv[16], qq[16], kk[16]; UNPK16(vv, v0, v1); UNPK16(qq, q0, q1); UNPK16(kk, k0, k1);
#pragma unroll
      for (int i = 0; i < 16; ++i) VT[(c0 + i) * TP + s] = f2bf(vv[i]);
      *(LAS u32x4*)(ST + s * TP + c0) = (u32x4){s0.x, s0.y, s0.z, s0.w}; *(LAS u32x4*)(ST + s * TP + c0 + 8) = (u32x4){s1.x, s1.y, s1.z, s1.w};
#pragma unroll
      for (int i = 0; i < 16; ++i) { const float cu = cum[s * 64 + c0 + i]; qq[i] = qq[i] * 0.125f * __expf(cu); kk[i] = kk[i] * __expf(-cu); }
      u32x4 w; w.x = pk_bf16(qq[0], qq[1]); w.y = pk_bf16(qq[2], qq[3]); w.z = pk_bf16(qq[4], qq[5]); w.w = pk_bf16(qq[6], qq[7]); *(LAS u32x4*)(QT + s * TP + c0) = w;
      w.x = pk_bf16(qq[8], qq[9]); w.y = pk_bf16(qq[10], qq[11]); w.z = pk_bf16(qq[12], qq[13]); w.w = pk_bf16(qq[14], qq[15]); *(LAS u32x4*)(QT + s * TP + c0 + 8) = w;
      w.x = pk_bf16(kk[0], kk[1]); w.y = pk_bf16(kk[2], kk[3]); w.z = pk_bf16(kk[4], kk[5]); w.w = pk_bf16(kk[6], kk[7]); *(LAS u32x4*)(KT + s * TP + c0) = w;
      w.x = pk_bf16(kk[8], kk[9]); w.y = pk_bf16(kk[10], kk[11]); w.z = pk_bf16(kk[12], kk[13]); w.w = pk_bf16(kk[14], kk[15]); *(LAS u32x4*)(KT + s * TP + c0 + 8) = w; }
    __syncthreads();
    f32x4 p[4], o[4];
#pragma unroll
    for (int n = 0; n < 4; ++n) { p[n] = (f32x4){0.f, 0.f, 0.f, 0.f}; o[n] = (f32x4){0.f, 0.f, 0.f, 0.f}; }
    mm_row4(p, QT, KT, T.tw, T.fr, T.g);
    mm_row4(o, QT, ST, T.tw, T.fr, T.g);
#pragma unroll
    for (int n = 0; n < 4; ++n)
#pragma unroll
        for (int r = 0; r < 4; ++r) { const int row = 16 * T.tw + 4 * T.g + r, col = n * 16 + T.fr; PT[row * TP + col] = f2bf(col <= row ? p[n][r] : 0.f); }
    __syncthreads();
    mm_row4(o, PT, VT, T.tw, T.fr, T.g);
#pragma unroll
    for (int r = 0; r < 4; ++r) {
        float ss = o[0][r] * o[0][r] + o[1][r] * o[1][r] + o[2][r] * o[2][r] + o[3][r] * o[3][r];
        ss += __shfl_xor(ss, 1); ss += __shfl_xor(ss, 2); ss += __shfl_xor(ss, 4); ss += __shfl_xor(ss, 8);
        const float rs = rsqrtf(ss * (1.f / 64.f) + 1e-5f); const size_t row = row0 + 16 * T.tw + 4 * T.g + r;
#pragma unroll
        for (int n = 0; n < 4; ++n) { const int col = n * 16 + T.fr; const float gt = bf2f(H[row * HLD + C_GG + hd * 64 + col]);
            O[row * DM + hd * 64 + col] = f2bf(o[n][r] * rs * norm_w[col] * silu_f(gt)); }
    }
    __syncthreads();
}
__device__ __forceinline__ void ph_gla_d(const bf16* H, const float* a_up, const float* a_bias, const bf16* GS, const float* norm_w, bf16* O) {
    MKTEAM();
    for (int ci = T.gteam; ci < 2048; ci += T.nteams) gla_d_item(T, ci, H, a_up, a_bias, GS, norm_w, O);
}


typedef float f32x16 __attribute__((ext_vector_type(16)));
typedef unsigned u32x2 __attribute__((ext_vector_type(2)));
constexpr float RW_LOGC = 0.6065306597126334f;
__device__ __forceinline__ void wr_nat4(LAS bf16* Tl, const f32x4 (&a)[4], int mt, int fr, int g) {
#pragma unroll
    for (int n = 0; n < 4; ++n)
#pragma unroll
        for (int r = 0; r < 4; ++r) Tl[(16 * mt + 4 * g + r) * TP + n * 16 + fr] = f2bf(a[n][r]);
}
__device__ __forceinline__ void wr_tr4(LAS bf16* Tl, const f32x4 (&a)[4], int mt, int fr, int g) {
#pragma unroll
    for (int n = 0; n < 4; ++n) *(LAS u32x2*)(Tl + (n * 16 + fr) * TP + 16 * mt + 4 * g) = (u32x2){pk_bf16(a[n][0], a[n][1]), pk_bf16(a[n][2], a[n][3])};
}
#define ZERO4(a) do { _Pragma("unroll") for (int n_ = 0; n_ < 4; ++n_) a[n_] = (f32x4){0.f, 0.f, 0.f, 0.f}; } while (0)
__device__ __forceinline__ void rwkv_b_item(int ci, int tid, const bf16* H, const float* mu, const float* w_up, const float* w0, const float* a_up, const float* a0,
                                            const float* k_k, const float* k_a, const float* r_k, bf16* GQ, bf16* GYL, bf16* GGP, bf16* GHC, float* GC, float* BON) {
    const int c = ci & 255, hd = (ci >> 8) & 3, b = ci >> 10; const size_t row0 = (size_t)b * SEQ + c * 64;
    const int w = __builtin_amdgcn_readfirstlane(tid >> 6); int lane = tid & 63, fr = lane & 15, g = lane >> 4, ch = hd * 64 + lane;
#define RELANE() do { int t_ = tid; asm volatile("" : "+v"(t_)); lane = t_ & 63; fr = lane & 15; g = lane >> 4; ch = hd * 64 + lane; } while (0)
    LAS unsigned char* L = (LAS unsigned char*)dyn_lds;
#define TILE(i) ((LAS bf16*)(L + (i) * TILE_B))
    LAS bf16 *At = TILE(0), *AtT = TILE(1), *Bt = TILE(2), *BtT = TILE(3), *Kt = TILE(4), *KtT = TILE(5), *Rt = TILE(6), *VT = TILE(7), *Pn = TILE(8), *PT = TILE(9), *Tn = TILE(10), *TT = TILE(11), *Aak = TILE(12), *Arb = TILE(13), *Ark = TILE(14);
    LAS bf16 *WtT = TILE(0), *X1T = TILE(2), *UtT = TILE(4);
    LAS float* lo = (LAS float*)(L + 8 * TILE_B); LAS float* tot = (LAS float*)(L + 15 * TILE_B); LAS float* gcs = tot + 512;
    float lw[8], av[8], bv[8], k2[8], rr[8], vv[8];
    {
        const float mu_r = mu[ch], mu_k = mu[256 + ch], mu_v = mu[512 + ch], mu_l = mu[1024 + lane];
        const bf16* hp = H + (row0 + 8 * w) * HLD + C_R0;
        float pr = 0.f, pk = 0.f, pv = 0.f, pl = 0.f;
        if (c != 0 || w != 0) { const bf16* q = hp - HLD; pr = bf2f(q[ch]); pk = bf2f(q[256 + ch]); pv = bf2f(q[512 + ch]); pl = bf2f(q[1024 + lane]); }
#pragma unroll
        for (int i = 0; i < 8; ++i) { const bf16* q = hp + (size_t)i * HLD; const float cr = bf2f(q[ch]), ck = bf2f(q[256 + ch]), cv = bf2f(q[512 + ch]), cl = bf2f(q[1024 + lane]);
            rr[i] = cr + (pr - cr) * mu_r; k2[i] = ck + (pk - ck) * mu_k; vv[i] = cv + (pv - cv) * mu_v; const float l_ = cl + (pl - cl) * mu_l;
            lo[lane * 64 + 8 * w + i] = (lane < 32) ? tanhf(l_) : l_;
            pr = cr; pk = ck; pv = cv; pl = cl; }
    }
    __syncthreads();
    RELANE();
    {
        float dd[8], aa[8];
        { const float w0c = w0[ch], a0c = a0[ch];
#pragma unroll
          for (int i = 0; i < 8; ++i) { dd[i] = w0c; aa[i] = a0c; } }
#pragma unroll 2
        for (int j = 0; j < 32; ++j) {
            const float wuj = w_up[j * 256 + ch], auj = a_up[j * 256 + ch];
            const f32x4 x0 = *(const LAS f32x4*)(lo + j * 64 + 8 * w), x1 = *(const LAS f32x4*)(lo + j * 64 + 8 * w + 4);
            const f32x4 y0 = *(const LAS f32x4*)(lo + (32 + j) * 64 + 8 * w), y1 = *(const LAS f32x4*)(lo + (32 + j) * 64 + 8 * w + 4);
#pragma unroll
            for (int i = 0; i < 4; ++i) { dd[i] += x0[i] * wuj; dd[4 + i] += x1[i] * wuj; aa[i] += y0[i] * auj; aa[4 + i] += y1[i] * auj; }
        }
        const float kkc = k_k[ch], kac = k_a[ch], rkc = r_k[ch];
#pragma unroll
        for (int i = 0; i < 8; ++i) {
            const float asig = sigmoid_f(aa[i]); lw[i] = -RW_LOGC * sigmoid_f(dd[i]);
            float kk = k2[i] * kkc; const float n2 = wave_sum(kk * kk); kk = kk / fmaxf(sqrtf(n2), 1e-12f);
            k2[i] = k2[i] * (1.f + (asig - 1.f) * kac);
            const float bonus = wave_sum(rr[i] * k2[i] * rkc);
            if (lane == 0) BON[(row0 + 8 * w + i) * 4 + hd] = bonus;
            av[i] = -kk; bv[i] = kk * asig;
        }
    }
    RELANE();
    float cum[8];
    { float a = 0.f;
#pragma unroll
      for (int i = 0; i < 8; ++i) { a += lw[i]; cum[i] = a; }
      tot[w * 64 + lane] = a; }
    __syncthreads();
    { float off = 0.f, all = 0.f;
#pragma unroll
      for (int j = 0; j < 8; ++j) { const float t_ = tot[j * 64 + lane]; all += t_; if (j < w) off += t_; }
#pragma unroll
      for (int i = 0; i < 8; ++i) cum[i] += off;
      const float gc = __expf(all);
      if (w == 0) { gcs[lane] = gc; GC[(size_t)ci * 64 + lane] = gc; } }
    RELANE();
    {
        float ta[8], tb[8], tk[8], tr[8];
#pragma unroll
        for (int i = 0; i < 8; ++i) { const float ep = __expf(cum[i]), en = __expf(-cum[i]), epv = __expf(cum[i] - lw[i]);
            ta[i] = av[i] * epv; tb[i] = bv[i] * en; tk[i] = k2[i] * en; tr[i] = rr[i] * ep;
            const int o = (8 * w + i) * TP + lane; At[o] = f2bf(ta[i]); Bt[o] = f2bf(tb[i]); Kt[o] = f2bf(tk[i]); Rt[o] = f2bf(tr[i]); }
        const int ot = lane * TP + 8 * w;
        *(LAS u32x4*)(AtT + ot) = (u32x4){pk_bf16(ta[0], ta[1]), pk_bf16(ta[2], ta[3]), pk_bf16(ta[4], ta[5]), pk_bf16(ta[6], ta[7])};
        *(LAS u32x4*)(BtT + ot) = (u32x4){pk_bf16(tb[0], tb[1]), pk_bf16(tb[2], tb[3]), pk_bf16(tb[4], tb[5]), pk_bf16(tb[6], tb[7])};
        *(LAS u32x4*)(KtT + ot) = (u32x4){pk_bf16(tk[0], tk[1]), pk_bf16(tk[2], tk[3]), pk_bf16(tk[4], tk[5]), pk_bf16(tk[6], tk[7])};
        *(LAS u32x4*)(VT + ot) = (u32x4){pk_bf16(vv[0], vv[1]), pk_bf16(vv[2], vv[3]), pk_bf16(vv[4], vv[5]), pk_bf16(vv[6], vv[7])};
    }
    __syncthreads();
    RELANE();
    const int mt = w & 3; const bool lowh = (w < 4);
    f32x4 x[4], y[4];
    ZERO4(x); ZERO4(y);
    if (lowh) { mm_row4(x, At, Bt, mt, fr, g); mm_row4(y, At, Kt, mt, fr, g); }
    else      { mm_row4(x, Rt, Bt, mt, fr, g); mm_row4(y, Rt, Kt, mt, fr, g); }
#pragma unroll
    for (int n = 0; n < 4; ++n)
#pragma unroll
        for (int r = 0; r < 4; ++r) { const int row = 16 * mt + 4 * g + r, col = 16 * n + fr; const bool keep = lowh ? (col < row) : (col <= row); if (!keep) { x[n][r] = 0.f; y[n][r] = 0.f; } }
    f32x4 tacc[4];
    ZERO4(tacc);
    if (lowh) { wr_nat4(Pn, x, mt, fr, g); wr_tr4(PT, x, mt, fr, g); wr_nat4(Aak, y, mt, fr, g);
#pragma unroll
        for (int n = 0; n < 4; ++n)
#pragma unroll
            for (int r = 0; r < 4; ++r) if (16 * mt + 4 * g + r == 16 * n + fr) x[n][r] += 1.f;
        wr_nat4(Tn, x, mt, fr, g); wr_tr4(TT, x, mt, fr, g); }
    else { wr_nat4(Arb, x, mt, fr, g); wr_nat4(Ark, y, mt, fr, g); }
    __syncthreads();
    RELANE();
    if (!lowh) {
#pragma unroll
        for (int n = 0; n < 4; ++n)
#pragma unroll
            for (int r = 0; r < 4; ++r) tacc[n][r] = bf2f(Tn[(16 * mt + 4 * g + r) * TP + n * 16 + fr]);
    }
#pragma unroll 1
    for (int p = 1; p <= 6; ++p) {
        RELANE();
        ZERO4(x);
        if (lowh) { if (p <= 5) mm_row4(x, Pn, PT, mt, fr, g); }
        else if (p >= 2) mm_row4(tacc, Pn, TT, mt, fr, g);
        __syncthreads();
        if (lowh) { if (p <= 5) { wr_nat4(Pn, x, mt, fr, g); wr_tr4(PT, x, mt, fr, g); } }
        else if (p >= 2) { wr_nat4(Tn, tacc, mt, fr, g); if (p <= 5) wr_tr4(TT, tacc, mt, fr, g); }
        __syncthreads();
    }
    RELANE();
    ZERO4(x);
    if (lowh) { mm_row4(x, Tn, AtT, mt, fr, g); wr_tr4(WtT, x, mt, fr, g); }
    else      { mm_row4(x, Aak, VT, mt, fr, g); wr_tr4(X1T, x, mt, fr, g); }
    __syncthreads();
    RELANE();
    ZERO4(x); ZERO4(y);
    if (lowh) { mm_row4(x, Tn, X1T, mt, fr, g); wr_tr4(UtT, x, mt, fr, g); }
    else {
        mm_row4(x, Arb, WtT, mt, fr, g);
#pragma unroll
        for (int n = 0; n < 4; ++n)
#pragma unroll
            for (int r = 0; r < 4; ++r) { const int row = 16 * mt + 4 * g + r, col = 16 * n + fr; GQ[(size_t)ci * 4096 + row * 64 + col] = f2bf(x[n][r] + bf2f(Rt[row * TP + col])); }
        mm_row4(y, WtT, BtT, mt, fr, g);
#pragma unroll
        for (int n = 0; n < 4; ++n) { const int j = 16 * n + fr; const float gc = gcs[j];
            *(u32x2*)(GGP + (size_t)ci * 4096 + j * 64 + mt * 16 + (g & 1) * 8 + (g >> 1) * 4) = (u32x2){pk_bf16(y[n][0] * gc, y[n][1] * gc), pk_bf16(y[n][2] * gc, y[n][3] * gc)}; }
    }
    __syncthreads();
    RELANE();
    ZERO4(x);
    if (lowh) { mm_row4(x, Arb, UtT, mt, fr, g); mm_row4(x, Ark, VT, mt, fr, g);
#pragma unroll
        for (int n = 0; n < 4; ++n)
#pragma unroll
            for (int r = 0; r < 4; ++r) GYL[(size_t)ci * 4096 + (16 * mt + 4 * g + r) * 64 + 16 * n + fr] = f2bf(x[n][r]);
    } else { mm_row4(x, UtT, BtT, mt, fr, g); mm_row4(x, VT, KtT, mt, fr, g);
#pragma unroll
        for (int n = 0; n < 4; ++n) { const int j = 16 * n + fr; const float gc = gcs[j];
#pragma unroll
            for (int r = 0; r < 4; ++r) GHC[(size_t)ci * 4096 + (16 * mt + 4 * g + r) * 64 + j] = f2bf(x[n][r] * gc); }
    }
    __syncthreads();
#undef TILE
#undef RELANE
}
__device__ __forceinline__ void ph_rwkv_b(const bf16* H, const float* mu, const float* w_up, const float* w0, const float* a_up, const float* a0, const float* k_k, const float* k_a, const float* r_k,
                                          bf16* GQ, bf16* GYL, bf16* GGP, bf16* GHC, float* GC, float* BON) {
    int tid = threadIdx.x; asm volatile("" : "+v"(tid));
    for (int ci = blockIdx.x; ci < 2048; ci += gridDim.x) rwkv_b_item(ci, tid, H, mu, w_up, w0, a_up, a0, k_k, k_a, r_k, GQ, GYL, GGP, GHC, GC, BON);
}
__device__ __forceinline__ void ph_rwkv_scan_fast(int sbv, const bf16* GGP, const bf16* GHC, const float* GC, bf16* GS2) {
    int tid = threadIdx.x; asm volatile("" : "+v"(tid)); sbv = __builtin_amdgcn_readfirstlane(sbv); asm volatile("" : "+s"(sbv));
    if (tid >= 64) return;
    const int lane = tid, l31 = lane & 31, h = lane >> 5, bh = sbv >> 1, v = (sbv & 1) * 32 + l31;
    f32x16 X[2];
#pragma unroll
    for (int r = 0; r < 16; ++r) { X[0][r] = 0.f; X[1][r] = 0.f; }
    for (int c = 0; c < 256; ++c) {
        const size_t ci = (size_t)bh * 256 + c;
        const bf16* gp = GGP + ci * 4096 + (size_t)l31 * 64 + h * 8; const bf16* hc = GHC + ci * 4096 + v * 64 + 4 * h; const float* gc = GC + ci * 64 + 4 * h; bf16* sp = GS2 + ci * 4096 + v * 64 + 4 * h;
        bf16x8 af[2][4]; u32x2 hv[2][4]; f32x4 gv[2][4];
#pragma unroll
        for (int kt = 0; kt < 2; ++kt)
#pragma unroll
            for (int q = 0; q < 4; ++q) { af[kt][q] = *(const bf16x8*)(gp + kt * 2048 + q * 16); hv[kt][q] = *(const u32x2*)(hc + 32 * kt + 8 * q); gv[kt][q] = *(const f32x4*)(gc + 32 * kt + 8 * q); }
        unsigned bw[2][8];
#pragma unroll
        for (int kt = 0; kt < 2; ++kt)
#pragma unroll
            for (int q = 0; q < 4; ++q) { bw[kt][2 * q] = pk_bf16(X[kt][4 * q], X[kt][4 * q + 1]); bw[kt][2 * q + 1] = pk_bf16(X[kt][4 * q + 2], X[kt][4 * q + 3]);
                *(u32x2*)(sp + 32 * kt + 8 * q) = (u32x2){bw[kt][2 * q], bw[kt][2 * q + 1]}; }
        f32x16 Xn[2];
#pragma unroll
        for (int kt = 0; kt < 2; ++kt)
#pragma unroll
            for (int q = 0; q < 4; ++q) { Xn[kt][4 * q + 0] = gv[kt][q][0] * X[kt][4 * q + 0] + bflo(hv[kt][q][0]); Xn[kt][4 * q + 1] = gv[kt][q][1] * X[kt][4 * q + 1] + bfhi(hv[kt][q][0]);
                                         Xn[kt][4 * q + 2] = gv[kt][q][2] * X[kt][4 * q + 2] + bflo(hv[kt][q][1]); Xn[kt][4 * q + 3] = gv[kt][q][3] * X[kt][4 * q + 3] + bfhi(hv[kt][q][1]); }
#pragma unroll
        for (int kt = 0; kt < 2; ++kt)
#pragma unroll
            for (int ks = 0; ks < 4; ++ks) { const u32x4 bq = (u32x4){bw[ks >> 1][4 * (ks & 1)], bw[ks >> 1][4 * (ks & 1) + 1], bw[ks >> 1][4 * (ks & 1) + 2], bw[ks >> 1][4 * (ks & 1) + 3]};
                Xn[kt] = __builtin_amdgcn_mfma_f32_32x32x16_bf16(af[kt][ks], __builtin_bit_cast(bf16x8, bq), Xn[kt], 0, 0, 0); }
        X[0] = Xn[0]; X[1] = Xn[1];
    }
}
__device__ __forceinline__ void rwkv_d_item(const Team& T, int ci, const bf16* H, const float* mu, const bf16* GQ, const bf16* GYL, const bf16* GS2, const float* BON, const float* gn_w, const float* gn_b, bf16* O) {
    const int c = ci & 255, hd = (ci >> 8) & 3, b = ci >> 10; const size_t row0 = (size_t)b * SEQ + c * 64;
    LAS bf16* QT = (LAS bf16*)T.lds; LAS bf16* ST = QT + 64 * TP;
    { const int s = T.ttid >> 2, c0 = (T.ttid & 3) * 16; const uint4* qp = (const uint4*)(GQ + (size_t)ci * 4096 + s * 64 + c0); const uint4* sp = (const uint4*)(GS2 + (size_t)ci * 4096 + s * 64 + c0);
      const uint4 q0 = qp[0], q1 = qp[1], s0 = sp[0], s1 = sp[1];
      *(LAS u32x4*)(QT + s * TP + c0) = (u32x4){q0.x, q0.y, q0.z, q0.w}; *(LAS u32x4*)(QT + s * TP + c0 + 8) = (u32x4){q1.x, q1.y, q1.z, q1.w};
      *(LAS u32x4*)(ST + s * TP + c0) = (u32x4){s0.x, s0.y, s0.z, s0.w}; *(LAS u32x4*)(ST + s * TP + c0 + 8) = (u32x4){s1.x, s1.y, s1.z, s1.w}; }
    __syncthreads();
    f32x4 y[4]; ZERO4(y);
    mm_row4(y, QT, ST, T.tw, T.fr, T.g);
#pragma unroll
    for (int r = 0; r < 4; ++r) {
        const int t = 16 * T.tw + 4 * T.g + r; const size_t row = row0 + t;
        float yv[4], sm = 0.f;
#pragma unroll
        for (int n = 0; n < 4; ++n) { yv[n] = y[n][r] + bf2f(GYL[(size_t)ci * 4096 + t * 64 + n * 16 + T.fr]); sm += yv[n]; }
        sm += __shfl_xor(sm, 1); sm += __shfl_xor(sm, 2); sm += __shfl_xor(sm, 4); sm += __shfl_xor(sm, 8);
        const float mean = sm * (1.f / 64.f); float sq = 0.f;
#pragma unroll
        for (int n = 0; n < 4; ++n) { yv[n] -= mean; sq += yv[n] * yv[n]; }
        sq += __shfl_xor(sq, 1); sq += __shfl_xor(sq, 2); sq += __shfl_xor(sq, 4); sq += __shfl_xor(sq, 8);
        const float rs = rsqrtf(sq * (1.f / 64.f) + 64e-5f), bon = BON[row * 4 + hd];
#pragma unroll
        for (int n = 0; n < 4; ++n) { const int chn = hd * 64 + n * 16 + T.fr;
            float o = yv[n] * rs * gn_w[chn] + gn_b[chn];
            o += bon * tshift(H, (int)row, C_R0 + 512 + chn, mu[512 + chn]);
            const float gt = tshift(H, (int)row, C_R0 + 768 + chn, mu[768 + chn]);
            O[row * DM + 768 + chn] = f2bf(o * silu_f(gt)); }
    }
    __syncthreads();
}
__device__ __forceinline__ void ph_rwkv_d(const bf16* H, const float* mu, const bf16* GQ, const bf16* GYL, const bf16* GS2, const float* BON, const float* gn_w, const float* gn_b, bf16* O) {
    MKTEAM();
    for (int ci = T.gteam; ci < 2048; ci += T.nteams) rwkv_d_item(T, ci, H, mu, GQ, GYL, GS2, BON, gn_w, gn_b, O);
}

__device__ __forceinline__ void ph_rwkv_pre(const bf16* H, const float* mu, const float* w_up, const float* w0, const float* a_up, const float* a0,
                                            const float* k_k, const float* k_a, const float* r_k, float* RW, bf16* RK, bf16* RA, bf16* RB, float* BON) {
    MKCTX();
    const int ch = c.vtid; LAS float* lo = (LAS float*)(c.lds + c.half * 65536);
    const int iters = (MTOK + c.nvb - 1) / c.nvb;
    for (int it = 0; it < iters; ++it) {
        const int t = it * c.nvb + c.vb; const bool act = t < MTOK;
        HALF_BAR();
        if (act) { if (ch < 32) lo[ch] = tanhf(tshift(H, t, C_R0 + 1024 + ch, mu[1024 + ch])); else if (ch < 64) lo[ch] = tshift(H, t, C_R0 + 1024 + ch, mu[1024 + ch]); }
        HALF_BAR();
        if (act) {
            const float r = tshift(H, t, C_R0 + ch, mu[ch]), k = tshift(H, t, C_R0 + 256 + ch, mu[256 + ch]);
            float d = w0[ch], aa = a0[ch];
#pragma unroll 8
            for (int j = 0; j < 32; ++j) { d += lo[j] * w_up[j * 256 + ch]; aa += lo[32 + j] * a_up[j * 256 + ch]; }
            const float a = sigmoid_f(aa), decay = expf(-0.6065306597126334f * sigmoid_f(d));
            float kk = k * k_k[ch]; const float n2 = wave_sum(kk * kk); kk = kk / fmaxf(sqrtf(n2), 1e-12f);
            const float k2 = k * (1.f + (a - 1.f) * k_a[ch]);
            const float bonus = wave_sum(r * k2 * r_k[ch]);
            const size_t o = (size_t)t * 256 + ch;
            RW[o] = decay; RK[o] = f2bf(k2); RA[o] = f2bf(-kk); RB[o] = f2bf(kk * a);
            if ((ch & 63) == 0) BON[(size_t)t * 4 + (ch >> 6)] = bonus;
        }
    }
}
__device__ __forceinline__ void ph_rwkv_scan(const bf16* H, const float* mu, const float* RW, const bf16* RK, const bf16* RA, const bf16* RB, float* RY) {
    MKCTX(); const int sb = c.vb - 16;
    const int b = sb >> 2, hd = sb & 3, tid = c.vtid, lane = tid & 63, v = (tid >> 6) * 16 + (lane >> 2), kq = lane & 3;
    LAS float* base = (LAS float*)(c.lds + c.half * 65536);
    LAS float* sr = base; LAS float* sw = base + 2048; LAS float* sk = base + 4096; LAS float* sv = base + 6144; LAS float* sa = base + 8192; LAS float* sbb = base + 10240;
    float s[16];
#pragma unroll
    for (int i = 0; i < 16; ++i) s[i] = 0.f;
    for (int t0 = 0; t0 < SEQ; t0 += 32) {
        HALF_BAR();
        for (int i = tid; i < 2048; i += 256) { const int tt = i >> 6, ch = i & 63; const int row = b * SEQ + t0 + tt; const size_t o = (size_t)row * 256 + hd * 64 + ch;
            sr[i] = bf2f(f2bf(tshift(H, row, C_R0 + hd * 64 + ch, mu[hd * 64 + ch]))); sv[i] = bf2f(f2bf(tshift(H, row, C_R0 + 512 + hd * 64 + ch, mu[512 + hd * 64 + ch])));
            sw[i] = RW[o]; sk[i] = bf2f(RK[o]); sa[i] = bf2f(RA[o]); sbb[i] = bf2f(RB[o]); }
        HALF_BAR();
        for (int tt = 0; tt < 32; ++tt) {
            float sA = 0.f;
#pragma unroll
            for (int i = 0; i < 16; ++i) sA += s[i] * sa[tt * 64 + kq * 16 + i];
            sA += __shfl_xor(sA, 1); sA += __shfl_xor(sA, 2);
            const float vv = sv[tt * 64 + v]; float y = 0.f;
#pragma unroll
            for (int i = 0; i < 16; ++i) { const int k = tt * 64 + kq * 16 + i; s[i] = s[i] * sw[k] + sA * sbb[k] + vv * sk[k]; y += s[i] * sr[k]; }
            y += __shfl_xor(y, 1); y += __shfl_xor(y, 2);
            if (kq == 0) RY[((size_t)b * SEQ + t0 + tt) * 256 + hd * 64 + v] = y;
        }
    }
}
__device__ __forceinline__ void ph_rwkv_post(const bf16* H, const float* mu, const float* RY, const float* BON, const float* gn_w, const float* gn_b, bf16* O) {
    MKCTX();
    const int ch = c.vtid;
    for (int t = c.vb; t < MTOK; t += c.nvb) {
        const float y = RY[(size_t)t * 256 + ch]; const float mean = wave_sum(y) * (1.f / 64.f); const float dl = y - mean; const float var = wave_sum(dl * dl) * (1.f / 64.f);
        float yn = dl * rsqrtf(var + 64e-5f) * gn_w[ch] + gn_b[ch];
        yn += BON[(size_t)t * 4 + (ch >> 6)] * tshift(H, t, C_R0 + 512 + ch, mu[512 + ch]);
        const float g = tshift(H, t, C_R0 + 768 + ch, mu[768 + ch]);
        O[(size_t)t * DM + 768 + ch] = f2bf(yn * silu_f(g));
    }
}
__device__ __forceinline__ void ph_moba_kbar(const bf16* H, float* KB) {
    MKCTX();
    LAS float* red = (LAS float*)(c.lds + c.half * 65536); const int tid = c.vtid, d = tid & 63, part = tid >> 6;
    const int iters = (BATCH * 8 * 64 + c.nvb - 1) / c.nvb;
    for (int it = 0; it < iters; ++it) {
        const int bid = it * c.nvb + c.vb; const bool act = bid < BATCH * 8 * 64; const int n = bid & 63, h = (bid >> 6) & 7, b = bid >> 9;
        float s = 0.f;
        if (act) for (int tt = 0; tt < 64; ++tt) s += bf2f(H[((size_t)b * SEQ + n * 256 + part * 64 + tt) * NPAD + C_MK + h * 64 + d]);
        HALF_BAR();
        red[part * 64 + d] = s;
        HALF_BAR();
        if (act && part == 0) KB[(size_t)bid * 64 + d] = (red[d] + red[64 + d] + red[128 + d] + red[192 + d]) * (1.f / 256.f);
    }
}

__device__ __forceinline__ int t5_bucket(int rel) {
    if (rel < 16) return rel;
    const int m = 31 - __clz(rel);
    int bkt = 16 + 2 * (m - 4) + (((unsigned)rel * (unsigned)rel >= (2u << (2 * m))) ? 1 : 0);
    return bkt > 31 ? 31 : bkt;
}
constexpr int KP = 72, VP = 260;
constexpr int MB_K = 0, MB_V = 256 * KP * 2, MB_BT = MB_V + 64 * VP * 2, MB_PFX = MB_BT + 16384 * 4, MB_END = MB_PFX + 1040 * 4;
static_assert(MB_END <= 147456, "MoBA LDS map");
constexpr float SC2 = 0.18033688011112042f, LOG2E = 1.4426950408889634f;
constexpr int LIST_PER_BH = 516096;
__device__ __forceinline__ int list_off(int bh, int n) { return bh * LIST_PER_BH + 16384 * n - 128 * n * (n + 1); }
__device__ __forceinline__ void ph_moba_kbar2(const bf16* H, bf16* KBH, bf16* KBL) {
    MKCTX();
    LAS float* red = (LAS float*)(c.lds + c.half * 65536); const int tid = c.vtid, d = tid & 63, part = tid >> 6;
    const int iters = (BATCH * 8 * 64 + c.nvb - 1) / c.nvb;
    for (int it = 0; it < iters; ++it) {
        const int bid = it * c.nvb + c.vb; const bool act = bid < BATCH * 8 * 64; const int n = bid & 63, h = (bid >> 6) & 7, b = bid >> 9;
        float s = 0.f;
        if (act) for (int tt = 0; tt < 64; ++tt) s += bf2f(H[((size_t)b * SEQ + n * 256 + part * 64 + tt) * HLD + C_MK + h * 64 + d]);
        HALF_BAR();
        red[part * 64 + d] = s;
        HALF_BAR();
        if (act && part == 0) { const float m = (red[d] + red[64 + d] + red[128 + d] + red[192 + d]) * (1.f / 256.f); const bf16 hi = f2bf(m);
            KBH[(size_t)((b * 8 + h) * 64 + n) * 64 + d] = hi; KBL[(size_t)((b * 8 + h) * 64 + n) * 64 + d] = f2bf(m - bf2f(hi)); }
    }
}
__device__ __forceinline__ unsigned gate_key(float v, int n) {
    const unsigned u = __float_as_uint(v); const unsigned o = (u & 0x80000000u) ? ~u : (u | 0x80000000u);
    return (o & ~63u) | (unsigned)(63 - n);
}
#define TOP3_INS(x_) do { unsigned x1_ = (x_); const unsigned a_ = max(k1, x1_); x1_ = min(k1, x1_); const unsigned b_ = max(k2, x1_); x1_ = min(k2, x1_); k1 = a_; k2 = b_; k3 = max(k3, x1_); } while (0)
__device__ __forceinline__ void ph_moba_gate(const bf16* H, const bf16* KBH, const bf16* KBL, unsigned* CNT, unsigned short* LIST, unsigned* SEL) {
    int tid = threadIdx.x; asm volatile("" : "+v"(tid));
    const int lane = tid & 63, l31 = lane & 31, hh = lane >> 5, gw0 = blockIdx.x * 8 + (tid >> 6), ngw = gridDim.x * 8;
    for (int task = gw0; task < 16 * 512; task += ngw) {
        const int bh = task >> 9, tile = task & 511, b = bh >> 3, h = bh & 7, own = tile >> 3;
        if (own == 0) continue;
        const int t = tile * 32 + l31;
        const bf16* qrow = H + ((size_t)b * SEQ + t) * HLD + C_MQ + h * 64 + hh * 8;
        bf16x8 qf[4];
#pragma unroll
        for (int ks = 0; ks < 4; ++ks) qf[ks] = *(const bf16x8*)(qrow + 16 * ks);
        f32x16 gsc[2];
#pragma unroll
        for (int nt = 0; nt < 2; ++nt) {
#pragma unroll
            for (int r = 0; r < 16; ++r) gsc[nt][r] = 0.f;
            if (32 * nt < own) {
                const bf16* kh = KBH + ((size_t)bh * 64 + 32 * nt + l31) * 64 + hh * 8; const bf16* kl = KBL + ((size_t)bh * 64 + 32 * nt + l31) * 64 + hh * 8;
#pragma unroll
                for (int ks = 0; ks < 4; ++ks) { gsc[nt] = __builtin_amdgcn_mfma_f32_32x32x16_bf16(*(const bf16x8*)(kh + 16 * ks), qf[ks], gsc[nt], 0, 0, 0);
                                                 gsc[nt] = __builtin_amdgcn_mfma_f32_32x32x16_bf16(*(const bf16x8*)(kl + 16 * ks), qf[ks], gsc[nt], 0, 0, 0); }
            }
        }
        unsigned k1 = 0u, k2 = 0u, k3 = 0u;
#pragma unroll
        for (int nt = 0; nt < 2; ++nt)
#pragma unroll
            for (int r = 0; r < 16; ++r) { const int n = 32 * nt + (r & 3) + 8 * (r >> 2) + 4 * hh; const unsigned key = (n < own) ? gate_key(gsc[nt][r], n) : 0u; TOP3_INS(key); }
        { const unsigned p1 = __shfl_xor(k1, 32), p2 = __shfl_xor(k2, 32), p3 = __shfl_xor(k3, 32); TOP3_INS(p1); TOP3_INS(p2); TOP3_INS(p3); }
        if (hh == 0) {
            const unsigned ks3[3] = {k1, k2, k3};
#ifdef MOBA_CHECK
            SEL[(size_t)bh * SEQ + t] = (63u - (k1 & 63u)) | ((63u - (k2 & 63u)) << 8) | ((63u - (k3 & 63u)) << 16);
#endif
#pragma unroll
            for (int j = 0; j < 3; ++j) if (j < own) { const int n = 63 - (int)(ks3[j] & 63u);
                const unsigned pos = atomicAdd(&CNT[bh * 64 + n], 1u);
                LIST[(size_t)list_off(bh, n) + pos] = (unsigned short)((t << 2) | j); }
        }
    }
}
__device__ __forceinline__ void moba_stage(LAS unsigned char* L, int tid, const bf16* H, const float* rel_bias, int b, int h, int n, int nrel) {
    LAS bf16* Kt = (LAS bf16*)(L + MB_K); LAS bf16* Vt = (LAS bf16*)(L + MB_V); LAS float* bt = (LAS float*)(L + MB_BT);
#pragma unroll
    for (int i = 0; i < 4; ++i) { const int id = tid + 512 * i, row = id >> 3, ch = id & 7; const bf16* src = H + ((size_t)b * SEQ + n * 256 + row) * HLD + h * 64 + ch * 8;
        const uint4 kv = *(const uint4*)(src + C_MK), vv = *(const uint4*)(src + C_MV);
        *(LAS u32x4*)(Kt + row * KP + ch * 8) = (u32x4){kv.x, kv.y, kv.z, kv.w};
        LAS bf16* vd = Vt + (ch * 8) * VP + row;
        vd[0] = (bf16)(vv.x & 0xffffu); vd[VP] = (bf16)(vv.x >> 16); vd[2 * VP] = (bf16)(vv.y & 0xffffu); vd[3 * VP] = (bf16)(vv.y >> 16);
        vd[4 * VP] = (bf16)(vv.z & 0xffffu); vd[5 * VP] = (bf16)(vv.z >> 16); vd[6 * VP] = (bf16)(vv.w & 0xffffu); vd[7 * VP] = (bf16)(vv.w >> 16); }
    for (int rel = tid; rel < nrel; rel += 512) bt[rel] = rel_bias[t5_bucket(rel) * 8 + h] * LOG2E;
}
#define MOBA_QK(kt_) do { s[kt_] = (f32x16){0.f,0.f,0.f,0.f,0.f,0.f,0.f,0.f,0.f,0.f,0.f,0.f,0.f,0.f,0.f,0.f}; _Pragma("unroll") for (int ks = 0; ks < 4; ++ks) \
    s[kt_] = __builtin_amdgcn_mfma_f32_32x32x16_bf16(*(const LAS bf16x8*)(Kt + (32 * (kt_) + l31) * KP + 16 * ks + 8 * hh), qf[ks], s[kt_], 0, 0, 0); } while (0)
#define MOBA_PV(kt_) do { _Pragma("unroll") for (int sp = 0; sp < 2; ++sp) { \
    const u32x4 pa = (u32x4){pk_bf16(s[kt_][8 * sp], s[kt_][8 * sp + 1]), pk_bf16(s[kt_][8 * sp + 2], s[kt_][8 * sp + 3]), pk_bf16(s[kt_][8 * sp + 4], s[kt_][8 * sp + 5]), pk_bf16(s[kt_][8 * sp + 6], s[kt_][8 * sp + 7])}; \
    _Pragma("unroll") for (int dt = 0; dt < 2; ++dt) { const LAS bf16* vp = Vt + (32 * dt + l31) * VP + 32 * (kt_) + 16 * sp + 4 * hh; const u32x2 v0 = *(const LAS u32x2*)vp, v1 = *(const LAS u32x2*)(vp + 8); \
        o[dt] = __builtin_amdgcn_mfma_f32_32x32x16_bf16(__builtin_bit_cast(bf16x8, pa), __builtin_bit_cast(bf16x8, ((u32x4){v0[0], v0[1], v1[0], v1[1]})), o[dt], 0, 0, 0); } } } while (0)
__device__ __forceinline__ void ph_moba_gather(int blk, int nblk, const bf16* H, const float* rel_bias, const unsigned* CNT, const unsigned short* LIST, bf16* PART, float* ML) {
    int tid = threadIdx.x; asm volatile("" : "+v"(tid));
    LAS unsigned char* L = (LAS unsigned char*)dyn_lds; LAS bf16* Kt = (LAS bf16*)(L + MB_K); LAS bf16* Vt = (LAS bf16*)(L + MB_V); LAS float* bt = (LAS float*)(L + MB_BT); LAS int* pfx = (LAS int*)(L + MB_PFX);
    const int lane = tid & 63, l31 = lane & 31, hh = lane >> 5, w = __builtin_amdgcn_readfirstlane(tid >> 6);
    { const int i0 = 2 * tid; const unsigned c0 = CNT[(i0 & 15) * 64 + (i0 >> 4)], c1 = CNT[((i0 + 1) & 15) * 64 + ((i0 + 1) >> 4)];
      const int n0 = (int)((c0 + 255u) >> 8), n1 = (int)((c1 + 255u) >> 8); int v = n0 + n1;
#pragma unroll
      for (int o = 1; o < 64; o <<= 1) { const int u = __shfl_up(v, o); if (lane >= o) v += u; }
      if (lane == 63) pfx[1028 + w] = v;
      __syncthreads();
      int base = 0;
#pragma unroll
      for (int j = 0; j < 8; ++j) if (j < w) base += pfx[1028 + j];
      pfx[i0 + 1] = base + v - n1; pfx[i0 + 2] = base + v; if (tid == 0) pfx[0] = 0;
      __syncthreads(); }
    const int total = pfx[1024];
    for (int j = blk; j < total; j += nblk) {
        int lo_ = 0, hi_ = 1024;
        while (hi_ - lo_ > 1) { const int mid = (lo_ + hi_) >> 1; if (pfx[mid] <= j) lo_ = mid; else hi_ = mid; }
        const int idx = lo_, sub = j - pfx[idx], n = idx >> 4, bh = idx & 15, b = bh >> 3, h = bh & 7;
        const int cnt = (int)CNT[bh * 64 + n];
        __syncthreads();
        moba_stage(L, tid, H, rel_bias, b, h, n, 16384);
        const int my = sub * 256 + 32 * w + l31; const bool valid = my < cnt;
        const unsigned e = LIST[(size_t)list_off(bh, n) + (valid ? my : 0)]; const int t = (int)(e >> 2), slot = (int)(e & 3u);
        const bf16* qrow = H + ((size_t)b * SEQ + t) * HLD + C_MQ + h * 64 + hh * 8;
        bf16x8 qf[4];
#pragma unroll
        for (int ks = 0; ks < 4; ++ks) qf[ks] = *(const bf16x8*)(qrow + 16 * ks);
        __syncthreads();
        if (sub * 256 + 32 * w < cnt) {
            f32x16 s[8];
#pragma unroll
            for (int kt = 0; kt < 8; ++kt) MOBA_QK(kt);
            const int relbase = t - n * 256 - 4 * hh; float m = -INFINITY;
#pragma unroll
            for (int kt = 0; kt < 8; ++kt)
#pragma unroll
                for (int r = 0; r < 16; ++r) { const int rel = relbase - (32 * kt + (r & 3) + 8 * (r >> 2)); s[kt][r] = s[kt][r] * SC2 + bt[rel]; m = fmaxf(m, s[kt][r]); }
            m = fmaxf(m, __shfl_xor(m, 32)); float l = 0.f;
#pragma unroll
            for (int kt = 0; kt < 8; ++kt)
#pragma unroll
                for (int r = 0; r < 16; ++r) { s[kt][r] = __builtin_amdgcn_exp2f(s[kt][r] - m); l += s[kt][r]; }
            l += __shfl_xor(l, 32);
            f32x16 o[2];
#pragma unroll
            for (int r = 0; r < 16; ++r) { o[0][r] = 0.f; o[1][r] = 0.f; }
#pragma unroll
            for (int kt = 0; kt < 8; ++kt) MOBA_PV(kt);
#pragma unroll
            for (int r = 0; r < 16; ++r) { const int qq = (r & 3) + 8 * (r >> 2) + 4 * hh; const unsigned ee = __shfl(e, qq); const int vq = __shfl((int)valid, qq);
                if (vq) { bf16* dst = PART + ((((size_t)bh * SEQ + (ee >> 2)) * 3 + (ee & 3u)) * 64 + l31); dst[0] = f2bf(o[0][r]); dst[32] = f2bf(o[1][r]); } }
            if (valid && hh == 0) { float* mp = ML + (((size_t)bh * SEQ + t) * 3 + slot) * 2; mp[0] = m; mp[1] = l; }
        }
    }
}
__device__ __forceinline__ void ph_moba_own(const bf16* H, const float* rel_bias, const bf16* PART, const float* ML, bf16* O) {
    int tid = threadIdx.x; asm volatile("" : "+v"(tid));
    LAS unsigned char* L = (LAS unsigned char*)dyn_lds; LAS bf16* Kt = (LAS bf16*)(L + MB_K); LAS bf16* Vt = (LAS bf16*)(L + MB_V); LAS float* bt = (LAS float*)(L + MB_BT);
    const int lane = tid & 63, l31 = lane & 31, hh = lane >> 5, w = __builtin_amdgcn_readfirstlane(tid >> 6);
    for (int item = blockIdx.x; item < 1024; item += gridDim.x) {
        const int bh = item >> 6, qb = item & 63, b = bh >> 3, h = bh & 7;
        __syncthreads();
        moba_stage(L, tid, H, rel_bias, b, h, qb, 256);
        const int tq = 32 * w + l31, t = qb * 256 + tq;
        const bf16* qrow = H + ((size_t)b * SEQ + t) * HLD + C_MQ + h * 64 + hh * 8;
        bf16x8 qf[4];
#pragma unroll
        for (int ks = 0; ks < 4; ++ks) qf[ks] = *(const bf16x8*)(qrow + 16 * ks);
        __syncthreads();
        float m = -INFINITY;
#pragma unroll 1
        for (int kt = 0; kt <= w; ++kt) {
            f32x16 s[1]; const LAS bf16* Kt0 = Kt; { const LAS bf16* Kt = Kt0 + 32 * kt * KP; MOBA_QK(0); }
#pragma unroll
            for (int r = 0; r < 16; ++r) { const int rel = tq - (32 * kt + (r & 3) + 8 * (r >> 2) + 4 * hh); const float v = s[0][r] * SC2 + bt[rel < 0 ? 0 : rel]; m = fmaxf(m, (rel >= 0) ? v : -INFINITY); }
        }
        m = fmaxf(m, __shfl_xor(m, 32)); float l = 0.f;
        f32x16 o[2];
#pragma unroll
        for (int r = 0; r < 16; ++r) { o[0][r] = 0.f; o[1][r] = 0.f; }
#pragma unroll 1
        for (int kt = 0; kt <= w; ++kt) {
            f32x16 s[1]; const LAS bf16* Kt0 = Kt; const LAS bf16* Vt0 = Vt; { const LAS bf16* Kt = Kt0 + 32 * kt * KP; MOBA_QK(0); }
#pragma unroll
            for (int r = 0; r < 16; ++r) { const int rel = tq - (32 * kt + (r & 3) + 8 * (r >> 2) + 4 * hh); const float v = s[0][r] * SC2 + bt[rel < 0 ? 0 : rel]; s[0][r] = (rel >= 0) ? __builtin_amdgcn_exp2f(v - m) : 0.f; l += s[0][r]; }
            { const LAS bf16* Vt = Vt0 + 32 * kt; MOBA_PV(0); }
        }
        l += __shfl_xor(l, 32);
        const int nval = qb < 3 ? qb : 3;
        float mj[3], lj[3], M = m;
#pragma unroll
        for (int j = 0; j < 3; ++j) { mj[j] = -INFINITY; lj[j] = 0.f; if (j < nval) { const float* mp = ML + (((size_t)bh * SEQ + t) * 3 + j) * 2; mj[j] = mp[0]; lj[j] = mp[1]; M = fmaxf(M, mj[j]); } }
        float c_own = __builtin_amdgcn_exp2f(m - M), cj[3], Lsum = c_own * l;
#pragma unroll
        for (int j = 0; j < 3; ++j) { cj[j] = (j < nval) ? __builtin_amdgcn_exp2f(mj[j] - M) : 0.f; Lsum += cj[j] * lj[j]; }
        const float inv = 1.f / Lsum; c_own *= inv;
#pragma unroll
        for (int j = 0; j < 3; ++j) cj[j] *= inv;
#pragma unroll
        for (int r = 0; r < 16; ++r) {
            const int qq = (r & 3) + 8 * (r >> 2) + 4 * hh; const int tt = qb * 256 + 32 * w + qq; const size_t row = (size_t)b * SEQ + tt;
            const float co = __shfl(c_own, qq); float v0 = o[0][r] * co, v1 = o[1][r] * co;
#pragma unroll
            for (int j = 0; j < 3; ++j) if (j < nval) { const float cc = __shfl(cj[j], qq); const bf16* src = PART + ((((size_t)bh * SEQ + tt) * 3 + j) * 64 + l31); v0 += cc * bf2f(src[0]); v1 += cc * bf2f(src[32]); }
            const bf16* gp = H + row * HLD + C_MG + h * 64 + l31; bf16* op = O + row * DM + 256 + h * 64 + l31;
            op[0] = f2bf(v0 * silu_f(bf2f(gp[0]))); op[32] = f2bf(v1 * silu_f(bf2f(gp[32])));
            if ((r & 3) == 3) __builtin_amdgcn_sched_barrier(0);
        }
    }
}


#ifdef MOBA_CHECK
__device__ __forceinline__ void moba_check(int row, int h, int lane, const bf16* H, const float* KB, const unsigned* SEL, const float* rel_bias, const bf16* O, unsigned* ERR) {
    const int b = row >> 14, tl = row & (SEQ - 1), own = tl >> 8, bh = b * 8 + h;
    const float NEG = -INFINITY;
    float q[64];
    { const uint4* qp = (const uint4*)(H + (size_t)row * HLD + C_MQ + h * 64);
#pragma unroll
      for (int i = 0; i < 8; ++i) { const uint4 u = qp[i]; q[8 * i + 0] = bflo(u.x); q[8 * i + 1] = bfhi(u.x); q[8 * i + 2] = bflo(u.y); q[8 * i + 3] = bfhi(u.y); q[8 * i + 4] = bflo(u.z); q[8 * i + 5] = bfhi(u.z); q[8 * i + 6] = bflo(u.w); q[8 * i + 7] = bfhi(u.w); } }
    float gsc = NEG;
    if (lane < own) { const float* kb = KB + ((size_t)bh * 64 + lane) * 64; float a = 0.f;
#pragma unroll
        for (int d = 0; d < 64; ++d) a += q[d] * kb[d];
        gsc = a; }
    const unsigned selw = SEL[(size_t)bh * SEQ + tl];
    int sel[3]; bool val[3]; int mism = 0;
#pragma unroll
    for (int r = 0; r < 3; ++r) { const float m = wave_max(gsc); const unsigned long long bal = __ballot(gsc == m); const int idx = __ffsll((long long)bal) - 1; val[r] = (r < own); sel[r] = (int)((selw >> (8 * r)) & 0xffu);
        if (val[r]) { bool found = false;
#pragma unroll
            for (int r2 = 0; r2 < 3; ++r2) if ((int)((selw >> (8 * r2)) & 0xffu) == idx && r2 < own) found = true;
            if (!found) mism = 1; }
        if (lane == idx) gsc = NEG; }
    float s[4][4];
    const bf16* Kb = H + (size_t)b * SEQ * HLD + C_MK + h * 64; const bf16* Vb = H + (size_t)b * SEQ * HLD + C_MV + h * 64;
#pragma unroll
    for (int j = 0; j < 4; ++j) {
        const int blk = (j < 3) ? sel[j] : own; const bool valid = (j < 3) ? val[j] : true;
#pragma unroll
        for (int cc = 0; cc < 4; ++cc) {
            float sc = NEG;
            if (valid && (blk * 256 + cc * 64 <= tl)) {
                const int kpos = blk * 256 + cc * 64 + lane;
                const uint4* kp = (const uint4*)(Kb + (size_t)kpos * HLD); float a = 0.f;
#pragma unroll
                for (int i = 0; i < 8; ++i) { const uint4 u = kp[i];
                    a += q[8 * i + 0] * bflo(u.x) + q[8 * i + 1] * bfhi(u.x) + q[8 * i + 2] * bflo(u.y) + q[8 * i + 3] * bfhi(u.y) + q[8 * i + 4] * bflo(u.z) + q[8 * i + 5] * bfhi(u.z) + q[8 * i + 6] * bflo(u.w) + q[8 * i + 7] * bfhi(u.w); }
                const int rel = tl - kpos;
                if (rel >= 0) sc = a * 0.125f + rel_bias[t5_bucket(rel) * 8 + h];
            }
            s[j][cc] = sc;
        }
    }
    float mx = NEG;
#pragma unroll
    for (int j = 0; j < 4; ++j)
#pragma unroll
        for (int cc = 0; cc < 4; ++cc) mx = fmaxf(mx, s[j][cc]);
    mx = wave_max(mx);
    float sum = 0.f;
#pragma unroll
    for (int j = 0; j < 4; ++j)
#pragma unroll
        for (int cc = 0; cc < 4; ++cc) { s[j][cc] = __expf(s[j][cc] - mx); sum += s[j][cc]; }
    sum = wave_sum(sum);
    float acc = 0.f;
#pragma unroll
    for (int j = 0; j < 4; ++j) {
        const int blk = (j < 3) ? sel[j] : own; const bool valid = (j < 3) ? val[j] : true;
#pragma unroll
        for (int cc = 0; cc < 4; ++cc) {
            if (valid && (blk * 256 + cc * 64 <= tl)) {
                const bf16* vp = Vb + (size_t)(blk * 256 + cc * 64) * HLD + lane; const float pj = s[j][cc];
                for (int i = 0; i < 64; ++i) acc += __shfl(pj, i) * bf2f(vp[(size_t)i * HLD]);
            }
        }
    }
    const float g = bf2f(H[(size_t)row * HLD + C_MG + h * 64 + lane]);
    const float ref = acc / sum * silu_f(g), got = bf2f(O[(size_t)row * DM + 256 + h * 64 + lane]);
    float e = fabsf(ref - got); if (!(e == e)) e = 1e3f;
    e = wave_max(e);
    if (lane == 0) { atomicMax(&ERR[0], __float_as_uint(e)); if (mism) atomicAdd(&ERR[1], 1u); }
}
#endif

__device__ __forceinline__ void moba_query(int row, int h, int lane, const bf16* H, const float* KB, const float* rel_bias, bf16* O) {
    const int b = row >> 14, tl = row & (SEQ - 1), own = tl >> 8;
    const float NEG = -INFINITY;
    float q[64];
    { const uint4* qp = (const uint4*)(H + (size_t)row * NPAD + C_MQ + h * 64);
#pragma unroll
      for (int i = 0; i < 8; ++i) { const uint4 u = qp[i]; q[8 * i + 0] = __uint_as_float(u.x << 16); q[8 * i + 1] = __uint_as_float(u.x & 0xffff0000u); q[8 * i + 2] = __uint_as_float(u.y << 16); q[8 * i + 3] = __uint_as_float(u.y & 0xffff0000u);
          q[8 * i + 4] = __uint_as_float(u.z << 16); q[8 * i + 5] = __uint_as_float(u.z & 0xffff0000u); q[8 * i + 6] = __uint_as_float(u.w << 16); q[8 * i + 7] = __uint_as_float(u.w & 0xffff0000u); } }
    float gsc = NEG;
    if (lane < own) { const float* kb = KB + ((size_t)(b * 8 + h) * 64 + lane) * 64; float a = 0.f;
#pragma unroll
        for (int d = 0; d < 64; ++d) a += q[d] * kb[d];
        gsc = a; }
    int sel[3]; bool val[3];
#pragma unroll
    for (int r = 0; r < 3; ++r) { const float m = wave_max(gsc); const unsigned long long bal = __ballot(gsc == m); const int idx = __ffsll((long long)bal) - 1; val[r] = (m > NEG); sel[r] = idx; if (lane == idx) gsc = NEG; }
    float s[4][4];
    const bf16* Kb = H + (size_t)b * SEQ * NPAD + C_MK + h * 64; const bf16* Vb = H + (size_t)b * SEQ * NPAD + C_MV + h * 64;
#pragma unroll
    for (int j = 0; j < 4; ++j) {
        const int blk = (j < 3) ? sel[j] : own; const bool valid = (j < 3) ? val[j] : true;
#pragma unroll
        for (int cc = 0; cc < 4; ++cc) {
            float sc = NEG;
            if (valid && (blk * 256 + cc * 64 <= tl)) {
                const int kpos = blk * 256 + cc * 64 + lane;
                const uint4* kp = (const uint4*)(Kb + (size_t)kpos * NPAD); float a = 0.f;
#pragma unroll
                for (int i = 0; i < 8; ++i) { const uint4 u = kp[i];
                    a += q[8 * i + 0] * __uint_as_float(u.x << 16) + q[8 * i + 1] * __uint_as_float(u.x & 0xffff0000u) + q[8 * i + 2] * __uint_as_float(u.y << 16) + q[8 * i + 3] * __uint_as_float(u.y & 0xffff0000u)
                       + q[8 * i + 4] * __uint_as_float(u.z << 16) + q[8 * i + 5] * __uint_as_float(u.z & 0xffff0000u) + q[8 * i + 6] * __uint_as_float(u.w << 16) + q[8 * i + 7] * __uint_as_float(u.w & 0xffff0000u); }
                const int rel = tl - kpos;
                if (rel >= 0) sc = a * 0.125f + rel_bias[t5_bucket(rel) * 8 + h];
            }
            s[j][cc] = sc;
        }
    }
    float mx = NEG;
#pragma unroll
    for (int j = 0; j < 4; ++j)
#pragma unroll
        for (int cc = 0; cc < 4; ++cc) mx = fmaxf(mx, s[j][cc]);
    mx = wave_max(mx);
    float sum = 0.f;
#pragma unroll
    for (int j = 0; j < 4; ++j)
#pragma unroll
        for (int cc = 0; cc < 4; ++cc) { s[j][cc] = __expf(s[j][cc] - mx); sum += s[j][cc]; }
    sum = wave_sum(sum);
    float acc = 0.f;
#pragma unroll
    for (int j = 0; j < 4; ++j) {
        const int blk = (j < 3) ? sel[j] : own; const bool valid = (j < 3) ? val[j] : true;
#pragma unroll
        for (int cc = 0; cc < 4; ++cc) {
            if (valid && (blk * 256 + cc * 64 <= tl)) {
                const bf16* vp = Vb + (size_t)(blk * 256 + cc * 64) * NPAD + lane; const float pj = s[j][cc];
                for (int i = 0; i < 64; ++i) acc += __shfl(pj, i) * bf2f(vp[(size_t)i * NPAD]);
            }
        }
    }
    const float g = bf2f(H[(size_t)row * NPAD + C_MG + h * 64 + lane]);
    O[(size_t)row * DM + 256 + h * 64 + lane] = f2bf(acc / sum * silu_f(g));
}
constexpr int LDS_BYTES = 147456;
__global__ void __launch_bounds__(512, 2) mega_fwd(Args args) {
    cg::grid_group grid = cg::this_grid();
#define WSP(T, off) ((T*)(args.ws + (off)))
#define DOP(T, off) ((T*)((unsigned char*)args.out + (off)))
#define INP(i, off) (args.in[i] + (size_t)(off))
    for (int l = 0; l < DEPTH; ++l) {
        ph_transpose_w(INP(1, (size_t)l * DM * D_IN), DM, D_IN, NPAD, WSP(bf16, WS_WIN + l * WIN_BYTES));
        ph_transpose_w(INP(2, (size_t)l * DM * DM), DM, DM, DM, WSP(bf16, WS_WOUT + l * WOUT_BYTES));
    }
    ph_cvt_x(args.in[0], WSP(bf16, WS_XN));
#ifdef MOBA_CHECK
    if (blockIdx.x == 0 && threadIdx.x < 2) WSP(unsigned, WS_ERR)[threadIdx.x] = 0u;
#endif
    grid.sync();
    for (int l = 0; l < DEPTH; ++l) {
        if (blockIdx.x == 0) { int t_ = threadIdx.x; asm volatile("" : "+v"(t_)); WSP(unsigned, WS_CNT)[t_] = 0u; WSP(unsigned, WS_CNT)[t_ + 512] = 0u; }
        { pg8::Gemm g{WSP(bf16, WS_XN), WSP(const bf16, WS_WIN + l * WIN_BYTES), MTOK, NPAD, DM};
          pg8::StaticOrder S; S.init(MTOK, NPAD, (int)gridDim.x, (int)blockIdx.x);
          pg8::EpiBf16<0> E{WSP(bf16, WS_H), NPAD, nullptr, 0, 0, 1.f};
          pg8::gemm_phase<pg8::EpiBf16<0>, pg8::StaticOrder, true, true>((LAS unsigned char*)dyn_lds, g, S, E); }
        grid.sync();
        ph_rwkv_b(WSP(bf16, WS_H), INP(7, l * 1088), INP(8, l * 32 * 256), INP(9, l * 256), INP(10, l * 32 * 256), INP(11, l * 256), INP(12, l * 256), INP(13, l * 256), INP(14, l * 256),
                  WSP(bf16, WS_GQ), WSP(bf16, WS_GYL), WSP(bf16, WS_GGP), WSP(bf16, WS_GHC), WSP(float, WS_GC), WSP(float, WS_BON));
        ph_moba_kbar2(WSP(bf16, WS_H), WSP(bf16, WS_KBH), WSP(bf16, WS_KBL));
#ifdef MOBA_CHECK
        ph_moba_kbar(WSP(bf16, WS_H), WSP(float, WS_KBF));
#endif
        ph_gla_b(WSP(bf16, WS_H), INP(3, l * 16 * 256), INP(4, l * 256), WSP(bf16, WS_GU), WSP(float, WS_GD));
        grid.sync();
        ph_moba_gate(WSP(bf16, WS_H), WSP(bf16, WS_KBH), WSP(bf16, WS_KBL), WSP(unsigned, WS_CNT), WSP(unsigned short, WS_LIST), WSP(unsigned, WS_SEL));
        grid.sync();
        if (blockIdx.x < 8) ph_gla_scan_fast(WSP(bf16, WS_GU), WSP(float, WS_GD), WSP(bf16, WS_GS));
        else if (blockIdx.x < 24) ph_rwkv_scan_fast((int)blockIdx.x - 8, WSP(bf16, WS_GGP), WSP(bf16, WS_GHC), WSP(float, WS_GC), WSP(bf16, WS_GS2));
        else ph_moba_gather((int)blockIdx.x - 24, (int)gridDim.x - 24, WSP(bf16, WS_H), args.in[6], WSP(unsigned, WS_CNT), WSP(unsigned short, WS_LIST), DOP(bf16, DO_PART), DOP(float, DO_ML));
        grid.sync();
        ph_moba_own(WSP(bf16, WS_H), args.in[6], DOP(bf16, DO_PART), DOP(float, DO_ML), WSP(bf16, WS_O));
        ph_gla_d(WSP(bf16, WS_H), INP(3, l * 16 * 256), INP(4, l * 256), WSP(bf16, WS_GS), INP(5, l * 64), WSP(bf16, WS_O));
        ph_rwkv_d(WSP(bf16, WS_H), INP(7, l * 1088), WSP(bf16, WS_GQ), WSP(bf16, WS_GYL), WSP(bf16, WS_GS2), WSP(float, WS_BON), INP(15, l * 256), INP(16, l * 256), WSP(bf16, WS_O));
        grid.sync();
#ifdef MOBA_CHECK
        { MKCTX(); const int lane = c.tid & 63; for (int k = blockIdx.x * 8 + (c.tid >> 6); 17 * k < MTOK * 8; k += gridDim.x * 8) { const int gw = 17 * k; moba_check(gw >> 3, gw & 7, lane, WSP(bf16, WS_H), WSP(float, WS_KBF), WSP(unsigned, WS_SEL), args.in[6], WSP(bf16, WS_O), WSP(unsigned, WS_ERR)); } }
        grid.sync();
#endif
        { pg8::Gemm g{WSP(bf16, WS_O), WSP(const bf16, WS_WOUT + l * WOUT_BYTES), MTOK, DM, DM};
          pg8::StaticOrder S; S.init(MTOK, DM, (int)gridDim.x, (int)blockIdx.x);
          pg8::EpiF32 E{WSP(float, WS_Y), DM, nullptr};
          pg8::gemm_phase<pg8::EpiF32, pg8::StaticOrder, true, true>((LAS unsigned char*)dyn_lds, g, S, E); }
        grid.sync();
        if (l + 1 < DEPTH) { ph_ln<false>(args.in[0], WSP(bf16, WS_XN), WSP(float, WS_Y), INP(17, l * DM), INP(18, l * DM), args.out); grid.sync(); }
        else ph_ln<true>(args.in[0], WSP(bf16, WS_XN), WSP(float, WS_Y), INP(17, l * DM), INP(18, l * DM), args.out);
    }
#ifdef MOBA_CHECK
    grid.sync();
    if (blockIdx.x == 0 && threadIdx.x == 0) { const float e = __uint_as_float(WSP(unsigned, WS_ERR)[0]); const unsigned mm = WSP(unsigned, WS_ERR)[1]; args.out[0] += 300.f * e; if (mm) args.out[1] += 0.3f + 0.01f * (float)mm; }
#endif
}
extern "C" void kernel_launch(void* const* d_in, const int* in_sizes, int n_in, void* d_out, int out_size, void* d_ws, size_t ws_size, hipStream_t stream) {
    static int grid = 0;
    if (grid == 0) {
        if (n_in != 19 || in_sizes[0] != MTOK * DM || out_size != MTOK * DM || ws_size < WS_NEED) { fprintf(stderr, "kernel_launch: unexpected shapes: n_in %d in0 %d out %d ws %zu\n", n_in, n_in > 0 ? in_sizes[0] : -1, out_size, ws_size); grid = -1; return; }
        int dev = 0, cus = 0, per_cu = 0;
        if (hipGetDevice(&dev) != hipSuccess || hipDeviceGetAttribute(&cus, hipDeviceAttributeMultiprocessorCount, dev) != hipSuccess) { fprintf(stderr, "kernel_launch: device query failed\n"); grid = -1; return; }
        if (hipFuncSetAttribute((const void*)mega_fwd, hipFuncAttributeMaxDynamicSharedMemorySize, LDS_BYTES) != hipSuccess) { fprintf(stderr, "kernel_launch: hipFuncSetAttribute failed\n"); grid = -1; return; }
        if (hipOccupancyMaxActiveBlocksPerMultiprocessor(&per_cu, (const void*)mega_fwd, 512, LDS_BYTES) != hipSuccess || per_cu < 1) { fprintf(stderr, "kernel_launch: occupancy query failed (%d)\n", per_cu); grid = -1; return; }
        grid = cus * 1;
        if (grid < 16) { grid = -1; return; }
    }
    if (grid < 0) return;
    Args a{};
    for (int i = 0; i < 19; ++i) a.in[i] = (const float*)d_in[i];
    a.out = (float*)d_out; a.ws = (unsigned char*)d_ws;
    void* kargs[] = {&a};
    hipError_t e = hipLaunchCooperativeKernel((const void*)mega_fwd, dim3(grid), dim3(512), kargs, LDS_BYTES, stream);
    if (e != hipSuccess) fprintf(stderr, "kernel_launch: cooperative launch failed: %s (grid %d)\n", hipGetErrorString(e), grid);
}
```

```cpp
#include <hip/hip_runtime.h>
#include <cstdio>
#include <cstdint>
#include <cmath>
namespace pg8 {
#define PG8_LAS __attribute__((address_space(3)))
typedef unsigned short bf16_t;
typedef short bf16x8 __attribute__((ext_vector_type(8)));
typedef float f32x4 __attribute__((ext_vector_type(4)));
typedef unsigned u32x4 __attribute__((ext_vector_type(4)));
constexpr int BM = 256, BK = 64, HALF = 128, HTB = HALF * BK * 2  , STAGE_BYTES = 8 * HTB, NXCD = 8, WGM = 8;

__host__ __device__ __forceinline__ int lds_byte(int r, int c) { const int st = (r >> 4) * 2 + (c >> 5), rr = r & 15, cc = c & 31, ob = rr * 64 + cc * 2; return st * 1024 + (ob ^ (((ob >> 9) & 1) << 5)); }
__host__ __device__ __forceinline__ void stage_rc(int b, int& R, int& C) { const int st = b / 1024, sb = b % 1024, swz = sb ^ (((sb >> 9) & 1) << 5); R = (st >> 1) * 16 + swz / 64; C = (st & 1) * 32 + (swz % 64) / 2; }
__host__ __device__ __forceinline__ int perm32(int rho) { const int n = rho >> 4, i = rho & 15; return 8 * (i >> 2) + 4 * n + (i & 3); }

struct Unit { int pm, pn; };
struct Gemm { const bf16_t* A; const bf16_t* Bt; int M, N, K; };

struct StaticOrder {
    int nM, nN, nwg, G, c;
    __host__ __device__ void init(int M, int N, int G_, int c_) { nM = M / BM; nN = N / BM; nwg = nM * nN; G = G_; c = c_; }
    __host__ __device__ bool next(int i, Unit& u) const {
        const long L = (long)i * G + c; if (L >= nwg) return false;
        int wgid = (int)L; { const int q = nwg / NXCD, r = nwg % NXCD, xcd = wgid % NXCD, off = wgid / NXCD; wgid = (xcd < r ? xcd * (q + 1) : r * (q + 1) + (xcd - r) * q) + off; }
        const int nig = WGM * nN, gid = wgid / nig, fm = gid * WGM, gsz = (nM - fm) < WGM ? (nM - fm) : WGM;
        u.pm = fm + ((wgid % nig) % gsz); u.pn = (wgid % nig) / gsz; return true;
    }
    __device__ __forceinline__ void a_ready(const Unit&) const {}
    __device__ __forceinline__ void done(const Unit&) const {}
};

__device__ __forceinline__ unsigned cvt_pk_bf16(float lo, float hi) { unsigned r; asm volatile("v_cvt_pk_bf16_f32 %0, %1, %2" : "=v"(r) : "v"(lo), "v"(hi)); return r; }
typedef float f32x2 __attribute__((ext_vector_type(2)));
__device__ __forceinline__ f32x2 gelu_pk(f32x2 v) {
    const f32x2 av = __builtin_elementwise_abs(v), d = av * 0.2316418882f + 1.0f;
    f32x2 t; t.x = __builtin_amdgcn_rcpf(d.x); t.y = __builtin_amdgcn_rcpf(d.y);
    f32x2 q = t * 0.5307027145f + (-0.7265760135f); q = q * t + 0.7107068705f; q = q * t + (-0.142248368f); q = q * t + 0.127414796f; q = q * t;
    const f32x2 s = (v * v) * (-0.72134752044f);
    f32x2 e; e.x = __builtin_amdgcn_exp2f(s.x); e.y = __builtin_amdgcn_exp2f(s.y);
    const f32x2 m = v * (q * e), r = v - m;
    f32x2 o; o.x = v.x < 0.f ? m.x : r.x; o.y = v.y < 0.f ? m.y : r.y; return o;
}

template <int ACT  > struct EpiBf16 {
    static constexpr bool PERM = true, AFTER_DRAIN = false; static_assert(ACT == 0 || ACT == 1, "EpiBf16: ACT is 0 (none) or 1 (gelu_pk)");
    bf16_t* O; int ldc; const float* bias; int split_cols; size_t split_stride; float scale0;
    __device__ __forceinline__ void operator()(const f32x4 (&acc)[2][2][4][2], const Unit& u, int wr, int wc, int fr, int fq) const {
        const int row0 = u.pm * BM + wr * 64 + fr; int colt = u.pn * BM; bf16_t* base = O;
        float sc = 1.f; if (split_cols) { const int t = colt / split_cols; base += (size_t)t * split_stride; colt -= t * split_cols; if (t == 0) sc = scale0; }
        const int col0 = colt + wc * 32 + 8 * fq, bcol0 = u.pn * BM + wc * 32 + 8 * fq;
        f32x4 bv[2][2];
#pragma unroll
        for (int bj = 0; bj < 2; ++bj)
#pragma unroll
            for (int n = 0; n < 2; ++n) bv[bj][n] = bias ? *(const f32x4*)(bias + bcol0 + bj * HALF + 4 * n) : (f32x4){0.f, 0.f, 0.f, 0.f};
#pragma unroll
        for (int ai = 0; ai < 2; ++ai)
#pragma unroll
            for (int m = 0; m < 4; ++m) { bf16_t* rowp = base + (size_t)(row0 + ai * HALF + m * 16) * ldc + col0;
#pragma unroll
                for (int bj = 0; bj < 2; ++bj) { f32x4 v0 = acc[ai][bj][m][0] + bv[bj][0], v1 = acc[ai][bj][m][1] + bv[bj][1];
                    if (ACT == 1) { f32x2 a = gelu_pk((f32x2){v0[0], v0[1]}), b = gelu_pk((f32x2){v0[2], v0[3]}), c = gelu_pk((f32x2){v1[0], v1[1]}), d = gelu_pk((f32x2){v1[2], v1[3]});
                        v0 = (f32x4){a.x, a.y, b.x, b.y}; v1 = (f32x4){c.x, c.y, d.x, d.y}; }
                    v0 = v0 * sc; v1 = v1 * sc; u32x4 w; w.x = cvt_pk_bf16(v0[0], v0[1]); w.y = cvt_pk_bf16(v0[2], v0[3]); w.z = cvt_pk_bf16(v1[0], v1[1]); w.w = cvt_pk_bf16(v1[2], v1[3]);
                    *(u32x4*)(rowp + bj * HALF) = w; } }
    }
};
struct EpiF32 {
    static constexpr bool PERM = false, AFTER_DRAIN = false;
    float* C; int ldc; const float* bias;
    __device__ __forceinline__ void operator()(const f32x4 (&acc)[2][2][4][2], const Unit& u, int wr, int wc, int fr, int fq) const {
        const int row0 = u.pm * BM + wr * 64 + fr, col0 = u.pn * BM + wc * 32 + 4 * fq;
        f32x4 bv[2][2];
#pragma unroll
        for (int bj = 0; bj < 2; ++bj)
#pragma unroll
            for (int n = 0; n < 2; ++n) bv[bj][n] = bias ? *(const f32x4*)(bias + col0 + bj * HALF + n * 16) : (f32x4){0.f, 0.f, 0.f, 0.f};
#pragma unroll
        for (int ai = 0; ai < 2; ++ai)
#pragma unroll
            for (int m = 0; m < 4; ++m) { float* rowp = C + (size_t)(row0 + ai * HALF + m * 16) * ldc + col0;
#pragma unroll
                for (int bj = 0; bj < 2; ++bj)
#pragma unroll
                    for (int n = 0; n < 2; ++n) *(f32x4*)(rowp + bj * HALF + n * 16) = acc[ai][bj][m][n] + bv[bj][n]; }
    }
};
template <class Epi, class Sched, bool ALIGN_EPI = false, bool SP2 = false>
__device__ __forceinline__ void gemm_phase(PG8_LAS unsigned char* lds, const Gemm g, const Sched& S, const Epi& E) {
    int tid_l = threadIdx.x; asm volatile("" : "+v"(tid_l));
    const int tid = tid_l, wid = __builtin_amdgcn_readfirstlane(tid >> 6), lane = tid & 63, wr = wid >> 2, wc = wid & 3, fr = lane & 15, fq = lane >> 4;
    const int K = g.K, nt = K / BK;
    unsigned voffA[2], voffB[2];
#pragma unroll
    for (int i = 0; i < 2; ++i) { int R, C; stage_rc(tid * 16 + i * 8192, R, C); const int Rb = Epi::PERM ? ((R & ~31) + perm32(R & 31)) : R;
        voffA[i] = (unsigned)(R * K + C) * 2u; voffB[i] = (unsigned)(Rb * K + C) * 2u; }
    const size_t kstep = (size_t)(BK * 2);
    const size_t hstep = (size_t)HALF * K * 2;
    const size_t tstep = 2 * hstep;
    const unsigned ldsw = (unsigned)wid * 1024u;
    const int aoff = lds_byte(wr * 64 + fr, fq * 8), boff = lds_byte(wc * 32 + fr, fq * 8);
#define PG8_SA(b, h) (((b) * 2 + (h)) * HTB)
#define PG8_SB(b, h) ((4 + (b) * 2 + (h)) * HTB)
#define PG8_STAGE(bufoff, gbase, voff) do { _Pragma("unroll") for (int _i = 0; _i < 2; ++_i) \
        __builtin_amdgcn_global_load_lds((const unsigned*)((const char*)(gbase) + (voff)[_i]), (PG8_LAS unsigned*)(lds + (bufoff) + ldsw + _i * 8192), 16, 0, 0); } while (0)
#define PG8_LDA(dst, b, h) do { _Pragma("unroll") for (int m = 0; m < 4; ++m) _Pragma("unroll") for (int k = 0; k < 2; ++k) dst[m][k] = *(const PG8_LAS bf16x8*)(lds + PG8_SA(b, h) + aoff + m * 2048 + k * 1024); } while (0)
#define PG8_LDB(dst, b, h) do { _Pragma("unroll") for (int n = 0; n < 2; ++n) _Pragma("unroll") for (int k = 0; k < 2; ++k) dst[n][k] = *(const PG8_LAS bf16x8*)(lds + PG8_SB(b, h) + boff + n * 2048 + k * 1024); } while (0)
#define PG8_MMA(ai, bj, At, Bt) do { __builtin_amdgcn_s_setprio(1); _Pragma("unroll") for (int m = 0; m < 4; ++m) _Pragma("unroll") for (int n = 0; n < 2; ++n) _Pragma("unroll") for (int k = 0; k < 2; ++k) \
        acc[ai][bj][m][n] = __builtin_amdgcn_mfma_f32_16x16x32_bf16(Bt[n][k], At[m][k], acc[ai][bj][m][n], 0, 0, 0); __builtin_amdgcn_s_setprio(0); } while (0)
#define PG8_WAIT_V(n) asm volatile("s_waitcnt vmcnt(" #n ")" ::: "memory")
#define PG8_WAIT_L(n) asm volatile("s_waitcnt lgkmcnt(" #n ")" ::: "memory")
#define PG8_BAR __builtin_amdgcn_s_barrier()
#define PG8_SCHED __builtin_amdgcn_sched_barrier(0)
    Unit cur, nxt; int ui = 0;
    if (!S.next(0, cur)) return;
    f32x4 acc[2][2][4][2];
#pragma unroll
    for (int a = 0; a < 2; ++a)
#pragma unroll
        for (int b = 0; b < 2; ++b)
#pragma unroll
            for (int m = 0; m < 4; ++m)
#pragma unroll
                for (int n = 0; n < 2; ++n) acc[a][b][m][n] = (f32x4){0.f, 0.f, 0.f, 0.f};
    bf16x8 At[4][2], B0[2][2], B1[2][2];
    const char* cA = (const char*)g.A + (size_t)cur.pm * tstep; const char* cB = (const char*)g.Bt + (size_t)cur.pn * tstep;
    S.a_ready(cur);
    if constexpr (SP2) {
        PG8_STAGE(PG8_SB(0, 0), cB, voffB); PG8_STAGE(PG8_SB(0, 1), cB + hstep, voffB); PG8_STAGE(PG8_SA(0, 0), cA, voffA); PG8_STAGE(PG8_SA(0, 1), cA + hstep, voffA);
        if (wr == 1) PG8_BAR;
        PG8_WAIT_V(2); PG8_BAR;
        PG8_STAGE(PG8_SB(1, 0), cB + kstep, voffB); PG8_STAGE(PG8_SA(1, 0), cA + kstep, voffA); PG8_STAGE(PG8_SB(1, 1), cB + hstep + kstep, voffB);
        PG8_WAIT_V(6); PG8_BAR;
    } else {
        PG8_STAGE(PG8_SB(0, 0), cB, voffB); PG8_STAGE(PG8_SA(0, 0), cA, voffA); PG8_STAGE(PG8_SB(0, 1), cB + hstep, voffB); PG8_STAGE(PG8_SA(0, 1), cA + hstep, voffA);
        if (wr == 1) PG8_BAR;
        PG8_WAIT_V(4); PG8_BAR;
        PG8_STAGE(PG8_SB(1, 0), cB + kstep, voffB); PG8_STAGE(PG8_SA(1, 0), cA + kstep, voffA); PG8_STAGE(PG8_SB(1, 1), cB + hstep + kstep, voffB);
        PG8_WAIT_V(6); PG8_BAR;
    }
    for (;;) {
        const bool has_next = S.next(ui + 1, nxt);
        const char* nA = has_next ? (const char*)g.A + (size_t)nxt.pm * tstep : cA; const char* nB = has_next ? (const char*)g.Bt + (size_t)nxt.pn * tstep : cB;
        for (int t = 0; t < nt; t += 2) {
            const bool last = (t == nt - 2);
            const char* a1 = cA + (size_t)(t + 1) * kstep;
            const char* a2 = last ? nA : cA + (size_t)(t + 2) * kstep; const char* b2 = last ? nB : cB + (size_t)(t + 2) * kstep;
            const char* a3 = a2 + kstep; const char* b3 = b2 + kstep;
            if (last && has_next) S.a_ready(nxt);
            if constexpr (SP2) {
            PG8_LDB(B0, 0, 0); PG8_LDB(B1, 0, 1); PG8_SCHED; PG8_LDA(At, 0, 0); PG8_STAGE(PG8_SA(1, 1), a1 + hstep, voffA);
            PG8_WAIT_V(8); PG8_WAIT_L(0); PG8_BAR; PG8_MMA(0, 0, At, B0); PG8_MMA(0, 1, At, B1); PG8_BAR; PG8_SCHED;
            PG8_LDA(At, 0, 1); PG8_STAGE(PG8_SB(0, 0), b2, voffB); PG8_STAGE(PG8_SB(0, 1), b2 + hstep, voffB); PG8_STAGE(PG8_SA(0, 0), a2, voffA);
            PG8_WAIT_V(8); PG8_WAIT_L(0); PG8_BAR; PG8_MMA(1, 0, At, B0); PG8_MMA(1, 1, At, B1); PG8_BAR; PG8_SCHED;
            PG8_LDB(B0, 1, 0); PG8_LDB(B1, 1, 1); PG8_SCHED; PG8_LDA(At, 1, 0); PG8_STAGE(PG8_SA(0, 1), a2 + hstep, voffA);
            PG8_WAIT_V(8); PG8_WAIT_L(0); PG8_BAR; PG8_MMA(0, 0, At, B0); PG8_MMA(0, 1, At, B1); PG8_BAR; PG8_SCHED;
            PG8_LDA(At, 1, 1); PG8_STAGE(PG8_SB(1, 0), b3, voffB); PG8_STAGE(PG8_SB(1, 1), b3 + hstep, voffB); PG8_STAGE(PG8_SA(1, 0), a3, voffA);
            PG8_WAIT_V(8); PG8_WAIT_L(0); PG8_BAR; PG8_MMA(1, 0, At, B0); PG8_MMA(1, 1, At, B1); PG8_BAR; PG8_SCHED;
            } else {
            PG8_LDB(B0, 0, 0); PG8_SCHED; PG8_LDA(At, 0, 0); PG8_STAGE(PG8_SA(1, 1), a1 + hstep, voffA);
            PG8_WAIT_L(8); PG8_BAR; PG8_WAIT_L(0); PG8_MMA(0, 0, At, B0); PG8_BAR; PG8_SCHED;
            PG8_LDB(B1, 0, 1); PG8_STAGE(PG8_SB(0, 0), b2, voffB);
            PG8_BAR; PG8_WAIT_L(0); PG8_MMA(0, 1, At, B1); PG8_BAR;
            PG8_LDA(At, 0, 1); PG8_STAGE(PG8_SA(0, 0), a2, voffA);
            PG8_BAR; PG8_WAIT_L(0); PG8_MMA(1, 0, At, B0); PG8_BAR; PG8_SCHED;
            PG8_STAGE(PG8_SB(0, 1), b2 + hstep, voffB);
            PG8_WAIT_V(6); PG8_BAR; PG8_MMA(1, 1, At, B1); PG8_BAR;
            PG8_LDB(B0, 1, 0); PG8_SCHED; PG8_LDA(At, 1, 0); PG8_STAGE(PG8_SA(0, 1), a2 + hstep, voffA);
            PG8_WAIT_L(8); PG8_BAR; PG8_WAIT_L(0); PG8_MMA(0, 0, At, B0); PG8_BAR; PG8_SCHED;
            PG8_LDB(B1, 1, 1); PG8_STAGE(PG8_SB(1, 0), b3, voffB);
            PG8_BAR; PG8_WAIT_L(0); PG8_MMA(0, 1, At, B1); PG8_BAR;
            PG8_LDA(At, 1, 1); PG8_STAGE(PG8_SA(1, 0), a3, voffA);
            PG8_BAR; PG8_WAIT_L(0); PG8_MMA(1, 0, At, B0); PG8_BAR; PG8_SCHED;
            PG8_STAGE(PG8_SB(1, 1), b3 + hstep, voffB);
            PG8_WAIT_V(6); PG8_BAR; PG8_MMA(1, 1, At, B1); PG8_BAR;
            }
        }
        if constexpr (ALIGN_EPI) { if (wr == 0) PG8_BAR; }
        if constexpr (!Epi::AFTER_DRAIN) { E(acc, cur, wr, wc, fr, fq); S.done(cur); }
        if (!has_next) break;
#pragma unroll
        for (int a = 0; a < 2; ++a)
#pragma unroll
            for (int b = 0; b < 2; ++b)
#pragma unroll
                for (int m = 0; m < 4; ++m)
#pragma unroll
                    for (int n = 0; n < 2; ++n) acc[a][b][m][n] = (f32x4){0.f, 0.f, 0.f, 0.f};
        cur = nxt; cA = nA; cB = nB; ++ui;
        if constexpr (ALIGN_EPI) { if (wr == 1) PG8_BAR; }
    }
    PG8_WAIT_V(0);
    if constexpr (!ALIGN_EPI) { if (wr == 0) PG8_BAR; }
    PG8_BAR;
    if constexpr (Epi::AFTER_DRAIN) { E.fused(acc, cur, wr, wc, fr, fq, lds, wid, lane); S.done(cur); }
#undef PG8_SA
#undef PG8_SB
#undef PG8_STAGE
#undef PG8_LDA
#undef PG8_LDB
#undef PG8_MMA
#undef PG8_WAIT_V
#undef PG8_WAIT_L
#undef PG8_BAR
#undef PG8_SCHED
}
}
#include <hip/hip_cooperative_groups.h>
namespace cg = cooperative_groups;
typedef unsigned short bf16;
#define LAS __attribute__((address_space(3)))
constexpr int BATCH = 2, SEQ = 16384, DM = 1024, DEPTH = 2, MTOK = BATCH * SEQ;
constexpr int D_IN = 4176, NPAD = 4352;
constexpr int C_GQ = 0, C_GK = 256, C_GV = 512, C_GG = 768, C_GA = 1024;
constexpr int C_MQ = 1040, C_MK = 1552, C_MV = 2064, C_MG = 2576;
constexpr int C_R0 = 3088;
constexpr float DN_ALPHA = 1.4142135623730951f;

__device__ __forceinline__ float bf2f(bf16 u) { return __uint_as_float(((unsigned)u) << 16); }
typedef float f32x2_t __attribute__((ext_vector_type(2))); typedef __bf16 bf16x2_t __attribute__((ext_vector_type(2)));
__device__ __forceinline__ unsigned pk_bf16(float lo, float hi) { const f32x2_t v = {lo, hi}; const bf16x2_t b = __builtin_convertvector(v, bf16x2_t); return __builtin_bit_cast(unsigned, b); }
__device__ __forceinline__ bf16 f2bf(float f) { return (bf16)(pk_bf16(f, 0.f) & 0xffffu); }
__device__ __forceinline__ float wave_sum(float v) {
#pragma unroll
    for (int o = 1; o < 64; o <<= 1) v += __shfl_xor(v, o);
    return v;
}
__device__ __forceinline__ float wave_max(float v) {
#pragma unroll
    for (int o = 1; o < 64; o <<= 1) v = fmaxf(v, __shfl_xor(v, o));
    return v;
}
__device__ __forceinline__ float silu_f(float g) { return g / (1.f + __expf(-g)); }
__device__ __forceinline__ float sigmoid_f(float z) { return 1.f / (1.f + __expf(-z)); }
__device__ __forceinline__ float bflo(unsigned u) { return __uint_as_float(u << 16); }
__device__ __forceinline__ float bfhi(unsigned u) { return __uint_as_float(u & 0xffff0000u); }
__device__ __forceinline__ float tshift(const bf16* H, int row, int col, float mu) {
    const bf16* p = H + (size_t)row * NPAD + col; const float cur = bf2f(p[0]); const float prv = (row & (SEQ - 1)) ? bf2f(p[-NPAD]) : 0.f; return cur + (prv - cur) * mu;
}

constexpr size_t MiB = (size_t)1 << 20;
constexpr size_t WS_CNT = 1 * MiB, WS_WIN = 2 * MiB, WIN_BYTES = (size_t)NPAD * DM * 2, WS_WOUT = 20 * MiB, WOUT_BYTES = (size_t)DM * DM * 2, WS_KBH = 24 * MiB, WS_KBL = 24 * MiB + 512 * 1024, WS_BON = 25 * MiB, WS_GD = 26 * MiB, WS_GC = 27 * MiB;
constexpr size_t WS_XN = 32 * MiB, WS_H = 96 * MiB, WS_Y = 96 * MiB, WS_O = 368 * MiB, WS_GU = 368 * MiB, WS_GGP = 384 * MiB, WS_GHC = 400 * MiB, WS_LIST = 416 * MiB;
constexpr size_t WS_GS = 432 * MiB, WS_GQ = 448 * MiB, WS_GYL = 464 * MiB, WS_GS2 = 480 * MiB, WS_NEED = 512 * MiB;
constexpr size_t WS_SEL = 28 * MiB, WS_KBF = 29 * MiB, WS_ERR = 0;
constexpr size_t WS_TS = 4096, WS_BAR = 16384, WS_CTL_BYTES = 65536;
constexpr size_t DO_PART = 0, DO_ML = 96 * MiB;
static_assert(WS_WIN + 2 * WIN_BYTES <= WS_WOUT && WS_WOUT + 2 * WOUT_BYTES <= WS_KBH && WS_H + (size_t)MTOK * NPAD * 2 <= WS_O && 16 * (size_t)516096 * 2 <= 16 * MiB, "ws map");
extern __shared__ __attribute__((aligned(16))) unsigned char dyn_lds[];
struct Args { const float* in[19]; float* out; unsigned char* ws; };
#define XB_TMO      128
#define XB_XCNT(j)  (256  + 64 * (j))
#define XB_XSUB(j)  (1280 + 64 * (j))
#define XB_XGEN(j)  (2304 + 64 * (j))
#define XB_TOP      3328
#define XB_TOPGEN   3392
#define XCD_BAR_WORDS 3456
#define XB_SPIN_CAP (1u << 18)

__device__ __forceinline__ unsigned xb_ld(unsigned* p)              { return __hip_atomic_load(p, __ATOMIC_RELAXED, __HIP_MEMORY_SCOPE_AGENT); }
__device__ __forceinline__ unsigned xb_add(unsigned* p, unsigned v) { return __hip_atomic_fetch_add(p, v, __ATOMIC_RELAXED, __HIP_MEMORY_SCOPE_AGENT); }
__device__ __forceinline__ unsigned xb_xcc_id() { return (unsigned)__builtin_amdgcn_s_getreg((3 << 11) | 20) & 0xFu; }
#define XB_SPIN(cond, bar) do { unsigned _sp = 0; while (cond) { __builtin_amdgcn_s_sleep(1); \
    if ((++_sp & 255u) == 0u) { if (xb_ld(&(bar)[XB_TMO])) break; if (_sp > XB_SPIN_CAP) { atomicAdd(&(bar)[XB_TMO], 1u); break; } } } } while (0)

struct XcdBarrier {
    unsigned* bar; unsigned x;
    volatile LAS unsigned* st;
};

__device__ __forceinline__ XcdBarrier xcd_barrier_post(unsigned* bar, volatile LAS unsigned* st) {
    XcdBarrier b; b.bar = bar; b.x = xb_xcc_id(); b.st = st;
    if (threadIdx.x == 0) (void)xb_add(&bar[XB_XCNT(b.x)], 1u);
    return b;
}
__device__ __forceinline__ void xcd_barrier_complete(unsigned* bar, unsigned x, unsigned& nloc, unsigned& nx) {
    const unsigned G = gridDim.x * gridDim.y * gridDim.z;
    unsigned sum, cnt, mine, sp = 0u;
    for (;;) {
        sum = 0u; cnt = 0u; mine = 0u;
#pragma unroll
        for (unsigned j = 0; j < 16; ++j) { const unsigned c = xb_ld(&bar[XB_XCNT(j)]); sum += c; cnt += (c > 0u) ? 1u : 0u; mine = (j == x) ? c : mine; }
        if (sum == G) break;
        __builtin_amdgcn_s_sleep(1);
        if ((++sp & 255u) == 0u) { if (xb_ld(&bar[XB_TMO])) break; if (sp > XB_SPIN_CAP) { atomicAdd(&bar[XB_TMO], 1u); break; } }
    }
    nloc = mine > 0u ? mine : 1u; nx = cnt > 0u ? cnt : 1u;
}

__device__ __forceinline__ void xcd_barrier(const XcdBarrier& b) {
    asm volatile("s_waitcnt vmcnt(0)" ::: "memory");
    __syncthreads();
    if (threadIdx.x == 0) {
        unsigned* bar = b.bar;
        __builtin_amdgcn_s_waitcnt(0);
        unsigned nloc = b.st[0], nx = b.st[1];
        if (nloc == 0u) { xcd_barrier_complete(bar, b.x, nloc, nx); b.st[0] = nloc; b.st[1] = nx; }
        const unsigned old = xb_add(&bar[XB_XSUB(b.x)], 1u);
        const unsigned gen = old / nloc;
        if (old + 1u == (gen + 1u) * nloc) {
            __builtin_amdgcn_fence(__ATOMIC_RELEASE, "agent");
            asm volatile("s_waitcnt vmcnt(0)" ::: "memory");
            const unsigned og = xb_add(&bar[XB_TOP], 1u);
            const unsigned tg = og / nx;
            if (og + 1u == (tg + 1u) * nx) xb_add(&bar[XB_TOPGEN], 1u);
            else XB_SPIN(xb_ld(&bar[XB_TOPGEN]) == tg, bar);
            __builtin_amdgcn_fence(__ATOMIC_ACQUIRE, "agent");
            xb_add(&bar[XB_XGEN(b.x)], 1u);
            asm volatile("s_waitcnt vmcnt(0)" ::: "memory");
        } else {
            XB_SPIN(xb_ld(&bar[XB_XGEN(b.x)]) == gen, bar);
            __builtin_amdgcn_fence(__ATOMIC_ACQUIRE, "agent");
            asm volatile("s_waitcnt vmcnt(0)" ::: "memory");
        }
    }
    __syncthreads();
}


#define LAUNDER_BG() int bx_ = blockIdx.x, gx_ = gridDim.x; asm volatile("" : "+s"(bx_), "+s"(gx_))
struct Ctx {
    LAS unsigned char* lds; int tid, vtid, half, vb, nvb, bx, gx;
};
#define HALF_BAR() __syncthreads()
#define MKCTX() Ctx c; { int t_ = threadIdx.x; asm volatile("" : "+v"(t_)); c.lds = (LAS unsigned char*)dyn_lds; c.tid = t_; c.vtid = t_ & 255; c.half = __builtin_amdgcn_readfirstlane(t_ >> 8); LAUNDER_BG(); c.vb = bx_ * 2 + c.half; c.nvb = gx_ * 2; c.bx = bx_; c.gx = gx_; }

__device__ __forceinline__ void ph_transpose_w(const float* W, int K, int N, int Npad, bf16* WT) {
    MKCTX();
    LAS float* tile = (LAS float*)(c.lds + c.half * 65536);
    const int nbx = Npad / 64, nitems = nbx * (K / 64), tid = c.vtid;
    const int iters = (nitems + c.nvb - 1) / c.nvb;
    for (int it = 0; it < iters; ++it) {
        const int item = it * c.nvb + c.vb; const bool act = item < nitems; const int n0 = (item % nbx) * 64, k0 = (item / nbx) * 64;
        HALF_BAR();
        if (act) for (int i = 0; i < 16; ++i) { const int k = i * 4 + (tid >> 6), n = tid & 63; tile[k * 65 + n] = (n0 + n < N) ? W[(size_t)(k0 + k) * N + n0 + n] : 0.f; }
        HALF_BAR();
        if (act) for (int i = 0; i < 16; ++i) { const int n = i * 4 + (tid >> 6), k = tid & 63; WT[(size_t)(n0 + n) * K + k0 + k] = f2bf(tile[k * 65 + n]); }
    }
}
__device__ __forceinline__ void ph_cvt_x(const float* x, bf16* xn) {
    MKCTX();
    const size_t n8 = (size_t)MTOK * DM / 8, stride = (size_t)c.nvb * 256;
    for (size_t i = (size_t)c.vb * 256 + c.vtid; i < n8; i += stride) {
        const float4 a = ((const float4*)x)[2 * i], b = ((const float4*)x)[2 * i + 1];
        uint4 o; o.x = f2bf(a.x) | ((unsigned)f2bf(a.y) << 16); o.y = f2bf(a.z) | ((unsigned)f2bf(a.w) << 16); o.z = f2bf(b.x) | ((unsigned)f2bf(b.y) << 16); o.w = f2bf(b.z) | ((unsigned)f2bf(b.w) << 16);
        ((uint4*)xn)[i] = o;
    }
}
template <bool LAST> __device__ __forceinline__ void ph_ln(const float* xin, bf16* xn, const float* y, const float* lw, const float* lb, float* out) {
    MKCTX();
    const int lane = c.tid & 63, gw = c.bx * 8 + (c.tid >> 6), ngw = c.gx * 8;
    for (int row = gw; row < MTOK; row += ngw) {
        const float4* yr = (const float4*)(y + (size_t)row * DM) + lane;
        float4 v[4]; float s = 0.f;
#pragma unroll
        for (int j = 0; j < 4; ++j) { float4 a;
            if (LAST) { const uint2 u = ((const uint2*)(xn + (size_t)row * DM))[lane + 64 * j]; a.x = bflo(u.x); a.y = bfhi(u.x); a.z = bflo(u.y); a.w = bfhi(u.y); }
            else a = ((const float4*)(xin + (size_t)row * DM))[lane + 64 * j];
            const float4 b = yr[64 * j]; v[j].x = DN_ALPHA * a.x + b.x; v[j].y = DN_ALPHA * a.y + b.y; v[j].z = DN_ALPHA * a.z + b.z; v[j].w = DN_ALPHA * a.w + b.w; s += (v[j].x + v[j].y) + (v[j].z + v[j].w); }
        const float mean = wave_sum(s) * (1.f / DM); float s2 = 0.f;
#pragma unroll
        for (int j = 0; j < 4; ++j) { v[j].x -= mean; v[j].y -= mean; v[j].z -= mean; v[j].w -= mean; s2 += (v[j].x * v[j].x + v[j].y * v[j].y) + (v[j].z * v[j].z + v[j].w * v[j].w); }
        const float rstd = rsqrtf(wave_sum(s2) * (1.f / DM) + 1e-5f);
#pragma unroll
        for (int j = 0; j < 4; ++j) { const float4 w = ((const float4*)lw)[lane + 64 * j], b = ((const float4*)lb)[lane + 64 * j];
            float4 o; o.x = v[j].x * rstd * w.x + b.x; o.y = v[j].y * rstd * w.y + b.y; o.z = v[j].z * rstd * w.z + b.z; o.w = v[j].w * rstd * w.w + b.w;
            if (LAST) ((float4*)(out + (size_t)row * DM))[lane + 64 * j] = o;
            else { uint2 p; p.x = pk_bf16(o.x, o.y); p.y = pk_bf16(o.z, o.w); ((uint2*)(xn + (size_t)row * DM))[lane + 64 * j] = p; } }
    }
}
__device__ __forceinline__ void ph_gla_scan(const bf16* H, const float* a_up, const float* a_bias, float* GO) {
    MKCTX(); const int sb = c.vb;
    const int b = sb >> 2, hd = sb & 3, tid = c.vtid, lane = tid & 63, v = (tid >> 6) * 16 + (lane >> 2), kq = lane & 3;
    LAS float* base = (LAS float*)(c.lds + c.half * 65536);
    LAS float* sq = base; LAS float* sk = base + 2048; LAS float* sv = base + 4096; LAS float* sa = base + 6144; LAS float* sdn = base + 8192;
    float s[16];
#pragma unroll
    for (int i = 0; i < 16; ++i) s[i] = 0.f;
    for (int t0 = 0; t0 < SEQ; t0 += 32) {
        HALF_BAR();
        for (int i = tid; i < 512; i += 256) { const int tt = i >> 4, j = i & 15; sdn[i] = bf2f(H[((size_t)b * SEQ + t0 + tt) * NPAD + C_GA + j]); }
        HALF_BAR();
        for (int i = tid; i < 2048; i += 256) { const int tt = i >> 6, ch = i & 63; const size_t row = (size_t)b * SEQ + t0 + tt; const bf16* hr = H + row * NPAD + hd * 64 + ch;
            sq[i] = bf2f(hr[C_GQ]) * 0.125f; sk[i] = bf2f(hr[C_GK]); sv[i] = bf2f(hr[C_GV]);
            float z = a_bias[hd * 64 + ch];
#pragma unroll
            for (int j = 0; j < 16; ++j) z += sdn[tt * 16 + j] * a_up[j * 256 + hd * 64 + ch];
            const float ls = fminf(z, 0.f) - log1pf(expf(-fabsf(z)));
            sa[i] = expf(ls * (1.f / 16.f)); }
        HALF_BAR();
        for (int tt = 0; tt < 32; ++tt) {
            const float vv = sv[tt * 64 + v]; float o = 0.f;
#pragma unroll
            for (int i = 0; i < 16; ++i) { const int k = tt * 64 + kq * 16 + i; s[i] = sa[k] * s[i] + sk[k] * vv; o += sq[k] * s[i]; }
            o += __shfl_xor(o, 1); o += __shfl_xor(o, 2);
            if (kq == 0) GO[((size_t)b * SEQ + t0 + tt) * 256 + hd * 64 + v] = o;
        }
    }
}
__device__ __forceinline__ void ph_gla_post(const bf16* H, const float* GO, const float* norm_w, bf16* O) {
    MKCTX();
    const int ch = c.vtid, lane = ch & 63;
    for (int t = c.vb; t < MTOK; t += c.nvb) {
        const float o = GO[(size_t)t * 256 + ch]; const float ms = wave_sum(o * o) * (1.f / 64.f);
        const float g = bf2f(H[(size_t)t * NPAD + C_GG + ch]);
        O[(size_t)t * DM + ch] = f2bf(o * rsqrtf(ms + 1e-5f) * norm_w[lane] * silu_f(g));
    }
}

typedef short bf16x8 __attribute__((ext_vector_type(8)));
typedef float f32x4 __attribute__((ext_vector_type(4)));
typedef unsigned u32x4 __attribute__((ext_vector_type(4)));
constexpr int HLD = NPAD;
constexpr int TP = 72, TILE_B = 64 * TP * 2;
constexpr int TEAM_LDS = 73728;
struct Team { LAS unsigned char* lds; int ttid, tw, lane, fr, g, team, gteam, nteams; };
#define MKTEAM() Team T; { int t_ = threadIdx.x; asm volatile("" : "+v"(t_)); T.team = __builtin_amdgcn_readfirstlane(t_ >> 8); T.lds = (LAS unsigned char*)dyn_lds + T.team * TEAM_LDS; T.ttid = t_ & 255; \
    T.tw = __builtin_amdgcn_readfirstlane((t_ >> 6) & 3); T.lane = t_ & 63; T.fr = T.lane & 15; T.g = T.lane >> 4; LAUNDER_BG(); T.gteam = bx_ * 2 + T.team; T.nteams = gx_ * 2; }
__device__ __forceinline__ void mm_row4(f32x4 (&acc)[4], const LAS bf16* A, const LAS bf16* Bt, int mt, int fr, int g) {
#pragma unroll
    for (int ks = 0; ks < 2; ++ks) {
        const bf16x8 a = *(const LAS bf16x8*)(A + (mt * 16 + fr) * TP + ks * 32 + g * 8);
#pragma unroll
        for (int n = 0; n < 4; ++n) { const bf16x8 b = *(const LAS bf16x8*)(Bt + (n * 16 + fr) * TP + ks * 32 + g * 8); acc[n] = __builtin_amdgcn_mfma_f32_16x16x32_bf16(a, b, acc[n], 0, 0, 0); }
    }
}
__device__ __forceinline__ void gla_cum(const Team& T, const bf16* H, size_t row0, int hd, const float* a_up, const float* a_bias, LAS float* adn, LAS float* cum) {
    { const int s = T.ttid >> 2, j0 = (T.ttid & 3) * 4; const uint2 u = *(const uint2*)(H + (row0 + s) * HLD + C_GA + j0);
      adn[s * 16 + j0 + 0] = bflo(u.x); adn[s * 16 + j0 + 1] = bfhi(u.x); adn[s * 16 + j0 + 2] = bflo(u.y); adn[s * 16 + j0 + 3] = bfhi(u.y); }
    const int k = T.ttid & 63; float au[16];
#pragma unroll
    for (int j = 0; j < 16; ++j) au[j] = a_up[j * 256 + hd * 64 + k];
    const float bias = a_bias[hd * 64 + k];
    __syncthreads();
#pragma unroll 4
    for (int i = 0; i < 16; ++i) { const int t = T.tw + 4 * i; float z = bias;
#pragma unroll
        for (int j = 0; j < 16; ++j) z += adn[t * 16 + j] * au[j];
        cum[t * 64 + k] = (fminf(z, 0.f) - log1pf(__expf(-fabsf(z)))) * (1.f / 16.f); }
    __syncthreads();
    if (T.ttid < 64) { float a = 0.f;
#pragma unroll 8
        for (int t = 0; t < 64; ++t) { a += cum[t * 64 + T.ttid]; cum[t * 64 + T.ttid] = a; } }
    __syncthreads();
}
#define UNPK16(dst, a, b) do { dst[0] = bflo(a.x); dst[1] = bfhi(a.x); dst[2] = bflo(a.y); dst[3] = bfhi(a.y); dst[4] = bflo(a.z); dst[5] = bfhi(a.z); dst[6] = bflo(a.w); dst[7] = bfhi(a.w); \
    dst[8] = bflo(b.x); dst[9] = bfhi(b.x); dst[10] = bflo(b.y); dst[11] = bfhi(b.y); dst[12] = bflo(b.z); dst[13] = bfhi(b.z); dst[14] = bflo(b.w); dst[15] = bfhi(b.w); } while (0)
__device__ __forceinline__ void gla_b_item(const Team& T, int ci, const bf16* H, const float* a_up, const float* a_bias, bf16* GU, float* GD) {
    const int c = ci & 255, hd = (ci >> 8) & 3, b = ci >> 10; const size_t row0 = (size_t)b * SEQ + c * 64;
    LAS float* adn = (LAS float*)T.lds; LAS float* cum = (LAS float*)(T.lds + 4096); LAS bf16* VT = (LAS bf16*)(T.lds + 20480); LAS bf16* KT = (LAS bf16*)(T.lds + 20480 + TILE_B);
    const int s = T.ttid >> 2, c0 = (T.ttid & 3) * 16;
    const bf16* hrow = H + (row0 + s) * HLD + hd * 64 + c0;
    const uint4 v0 = *(const uint4*)(hrow + C_GV), v1 = *(const uint4*)(hrow + C_GV + 8), k0 = *(const uint4*)(hrow + C_GK), k1 = *(const uint4*)(hrow + C_GK + 8);
    gla_cum(T, H, row0, hd, a_up, a_bias, adn, cum);
    { float vv[16], kk[16]; UNPK16(vv, v0, v1); UNPK16(kk, k0, k1);
#pragma unroll
      for (int i = 0; i < 16; ++i) { VT[(c0 + i) * TP + s] = f2bf(vv[i]); KT[(c0 + i) * TP + s] = f2bf(kk[i] * __expf(cum[63 * 64 + c0 + i] - cum[s * 64 + c0 + i])); } }
    if (T.ttid < 64) GD[(size_t)ci * 64 + T.ttid] = __expf(cum[63 * 64 + T.ttid]);
    __syncthreads();
    f32x4 acc[4];
#pragma unroll
    for (int n = 0; n < 4; ++n) acc[n] = (f32x4){0.f, 0.f, 0.f, 0.f};
    mm_row4(acc, VT, KT, T.tw, T.fr, T.g);
#pragma unroll
    for (int n = 0; n < 4; ++n)
#pragma unroll
        for (int r = 0; r < 4; ++r) GU[(size_t)ci * 4096 + (16 * T.tw + 4 * T.g + r) * 64 + n * 16 + T.fr] = f2bf(acc[n][r]);
    __syncthreads();
}
__device__ __forceinline__ void ph_gla_b(const bf16* H, const float* a_up, const float* a_bias, bf16* GU, float* GD) {
    MKTEAM();
    for (int ci = T.gteam; ci < 2048; ci += T.nteams) gla_b_item(T, ci, H, a_up, a_bias, GU, GD);
}
__device__ __forceinline__ void ph_gla_scan_fast(const bf16* GU, const float* GD, bf16* GS) {
    int tid = threadIdx.x; asm volatile("" : "+v"(tid)); LAUNDER_BG();
    const int sb = bx_, e0 = tid * 8, k0 = e0 & 63;
    float S[8];
#pragma unroll
    for (int i = 0; i < 8; ++i) S[i] = 0.f;
    const bf16* up = GU + (size_t)sb * 256 * 4096 + e0; const float* dp = GD + (size_t)sb * 256 * 64 + k0; bf16* sp = GS + (size_t)sb * 256 * 4096 + e0;
    uint4 u = *(const uint4*)up; float4 d0 = ((const float4*)dp)[0], d1 = ((const float4*)dp)[1];
    for (int c = 0; c < 256; ++c) {
        uint4 nu = u; float4 nd0 = d0, nd1 = d1;
        if (c + 1 < 256) { nu = *(const uint4*)(up + (size_t)(c + 1) * 4096); nd0 = ((const float4*)(dp + (c + 1) * 64))[0]; nd1 = ((const float4*)(dp + (c + 1) * 64))[1]; }
        uint4 o; o.x = pk_bf16(S[0], S[1]); o.y = pk_bf16(S[2], S[3]); o.z = pk_bf16(S[4], S[5]); o.w = pk_bf16(S[6], S[7]);
        *(uint4*)(sp + (size_t)c * 4096) = o;
        S[0] = d0.x * S[0] + bflo(u.x); S[1] = d0.y * S[1] + bfhi(u.x); S[2] = d0.z * S[2] + bflo(u.y); S[3] = d0.w * S[3] + bfhi(u.y);
        S[4] = d1.x * S[4] + bflo(u.z); S[5] = d1.y * S[5] + bfhi(u.z); S[6] = d1.z * S[6] + bflo(u.w); S[7] = d1.w * S[7] + bfhi(u.w);
        u = nu; d0 = nd0; d1 = nd1;
    }
}
__device__ __forceinline__ void gla_d_item(const Team& T, int ci, const bf16* H, const float* a_up, const float* a_bias, const bf16* GS, const float* norm_w, bf16* O) {
    const int c = ci & 255, hd = (ci >> 8) & 3, b = ci >> 10; const size_t row0 = (size_t)b * SEQ + c * 64;
    LAS float* adn = (LAS float*)T.lds; LAS float* cum = (LAS float*)(T.lds + 4096);
    LAS bf16* QT = (LAS bf16*)(T.lds + 20480); LAS bf16* KT = QT + 64 * TP; LAS bf16* VT = KT + 64 * TP; LAS bf16* ST = VT + 64 * TP; LAS bf16* PT = ST + 64 * TP;
    const int s = T.ttid >> 2, c0 = (T.ttid & 3) * 16;
    const bf16* hrow = H + (row0 + s) * HLD + hd * 64 + c0;
    const uint4 q0 = *(const uint4*)(hrow + C_GQ), q1 = *(const uint4*)(hrow + C_GQ + 8), k0 = *(const uint4*)(hrow + C_GK), k1 = *(const uint4*)(hrow + C_GK + 8);
    const uint4 v0 = *(const uint4*)(hrow + C_GV), v1 = *(const uint4*)(hrow + C_GV + 8);
    const uint4 s0 = *(const uint4*)(GS + (size_t)ci * 4096 + s * 64 + c0), s1 = *(const uint4*)(GS + (size_t)ci * 4096 + s * 64 + c0 + 8);
    gla_cum(T, H, row0, hd, a_up, a_bias, adn, cum);
    { float vv[16], qq[16], kk[16]; UNPK16(vv, v0, v1); UNPK16(qq, q0, q1); UNPK16(kk, k0, k1);
#pragma unroll
      for (int i = 0; i < 16; ++i) VT[(c0 + i) * TP + s] = f2bf(vv[i]);
      *(LAS u32x4*)(ST + s * TP + c0) = (u32x4){s0.x, s0.y, s0.z, s0.w}; *(LAS u32x4*)(ST + s * TP + c0 + 8) = (u32x4){s1.x, s1.y, s1.z, s1.w};
#pragma unroll
      for (int i = 0; i < 16; ++i) { const float cu = cum[s * 64 + c0 + i]; qq[i] = qq[i] * 0.125f * __expf(cu); kk[i] = kk[i] * __expf(-cu); }
      u32x4 w; w.x = pk_bf16(qq[0], qq[1]); w.y = pk_bf16(qq[2], qq[3]); w.z = pk_bf16(qq[4], qq[5]); w.w = pk_bf16(qq[6], qq[7]); *(LAS u32x4*)(QT + s * TP + c0) = w;
      w.x = pk_bf16(qq[8], qq[9]); w.y = pk_bf16(qq[10], qq[11]); w.z = pk_bf16(qq[12], qq[13]); w.w = pk_bf16(qq[14], qq[15]); *(LAS u32x4*)(QT + s * TP + c0 + 8) = w;
      w.x = pk_bf16(kk[0], kk[1]); w.y = pk_bf16(kk[2], kk[3]); w.z = pk_bf16(kk[4], kk[5]); w.w = pk_bf16(kk[6], kk[7]); *(LAS u32x4*)(KT + s * TP + c0) = w;
      w.x = pk_bf16(kk[8], kk[9]); w.y = pk_bf16(kk[10], kk[11]); w.z = pk_bf16(kk[12], kk[13]); w.w = pk_bf16(kk[14], kk[15]); *(LAS u32x4*)(KT + s * TP + c0 + 8) = w; }
    __syncthreads();
    f32x4 p[4], o[4];
#pragma unroll
    for (int n = 0; n < 4; ++n) { p[n] = (f32x4){0.f, 0.f, 0.f, 0.f}; o[n] = (f32x4){0.f, 0.f, 0.f, 0.f}; }
    mm_row4(p, QT, KT, T.tw, T.fr, T.g);
    mm_row4(o, QT, ST, T.tw, T.fr, T.g);
#pragma unroll
    for (int n = 0; n < 4; ++n)
#pragma unroll
        for (int r = 0; r < 4; ++r) { const int row = 16 * T.tw + 4 * T.g + r, col = n * 16 + T.fr; PT[row * TP + col] = f2bf(col <= row ? p[n][r] : 0.f); }
    __syncthreads();
    mm_row4(o, PT, VT, T.tw, T.fr, T.g);
#pragma unroll
    for (int r = 0; r < 4; ++r) {
        float ss = o[0][r] * o[0][r] + o[1][r] * o[1][r] + o[2][r] * o[2][r] + o[3][r] * o[3][r];
        ss += __shfl_xor(ss, 1); ss += __shfl_xor(ss, 2); ss += __shfl_xor(ss, 4); ss += __shfl_xor(ss, 8);
        const float rs = rsqrtf(ss * (1.f / 64.f) + 1e-5f); const size_t row = row0 + 16 * T.tw + 4 * T.g + r;
#pragma unroll
        for (int n = 0; n < 4; ++n) { const int col = n * 16 + T.fr; const float gt = bf2f(H[row * HLD + C_GG + hd * 64 + col]);
            O[row * DM + hd * 64 + col] = f2bf(o[n][r] * rs * norm_w[col] * silu_f(gt)); }
    }
    __syncthreads();
}
__device__ __forceinline__ void ph_gla_d(const bf16* H, const float* a_up, const float* a_bias, const bf16* GS, const float* norm_w, bf16* O) {
    MKTEAM();
    for (int ci = T.gteam; ci < 2048; ci += T.nteams) gla_d_item(T, ci, H, a_up, a_bias, GS, norm_w, O);
}


typedef float f32x16 __attribute__((ext_vector_type(16)));
typedef unsigned u32x2 __attribute__((ext_vector_type(2)));
constexpr float RW_LOGC = 0.6065306597126334f;
__device__ __forceinline__ void wr_nat4(LAS bf16* Tl, const f32x4 (&a)[4], int mt, int fr, int g) {
#pragma unroll
    for (int n = 0; n < 4; ++n)
#pragma unroll
        for (int r = 0; r < 4; ++r) Tl[(16 * mt + 4 * g + r) * TP + n * 16 + fr] = f2bf(a[n][r]);
}
__device__ __forceinline__ void wr_tr4(LAS bf16* Tl, const f32x4 (&a)[4], int mt, int fr, int g) {
#pragma unroll
    for (int n = 0; n < 4; ++n) *(LAS u32x2*)(Tl + (n * 16 + fr) * TP + 16 * mt + 4 * g) = (u32x2){pk_bf16(a[n][0], a[n][1]), pk_bf16(a[n][2], a[n][3])};
}
#define ZERO4(a) do { _Pragma("unroll") for (int n_ = 0; n_ < 4; ++n_) a[n_] = (f32x4){0.f, 0.f, 0.f, 0.f}; } while (0)
__device__ __forceinline__ void rwkv_b_item(int ci, int tid, const bf16* H, const float* mu, const float* w_up, const float* w0, const float* a_up, const float* a0,
                                            const float* k_k, const float* k_a, const float* r_k, bf16* GQ, bf16* GYL, bf16* GGP, bf16* GHC, float* GC, float* BON) {
    const int c = ci & 255, hd = (ci >> 8) & 3, b = ci >> 10; const size_t row0 = (size_t)b * SEQ + c * 64;
    const int w = __builtin_amdgcn_readfirstlane(tid >> 6); int lane = tid & 63, fr = lane & 15, g = lane >> 4, ch = hd * 64 + lane;
#define RELANE() do { int t_ = tid; asm volatile("" : "+v"(t_)); lane = t_ & 63; fr = lane & 15; g = lane >> 4; ch = hd * 64 + lane; } while (0)
    LAS unsigned char* L = (LAS unsigned char*)dyn_lds;
#define TILE(i) ((LAS bf16*)(L + (i) * TILE_B))
    LAS bf16 *At = TILE(0), *AtT = TILE(1), *Bt = TILE(2), *BtT = TILE(3), *Kt = TILE(4), *KtT = TILE(5), *Rt = TILE(6), *VT = TILE(7), *Pn = TILE(8), *PT = TILE(9), *Tn = TILE(10), *TT = TILE(11), *Aak = TILE(12), *Arb = TILE(13), *Ark = TILE(14);
    LAS bf16 *WtT = TILE(0), *X1T = TILE(2), *UtT = TILE(4);
    LAS float* lo = (LAS float*)(L + 8 * TILE_B); LAS float* tot = (LAS float*)(L + 15 * TILE_B); LAS float* gcs = tot + 512;
    LAS float* wlds = (LAS float*)(L + 10 * TILE_B); LAS float* alds = wlds + 2048;
    float lw[8], av[8], bv[8], k2[8], rr[8], vv[8];
    {
        { float wv_[4], av_[4];
#pragma unroll
          for (int i = 0; i < 4; ++i) { const int id = tid + 512 * i; wv_[i] = w_up[(id >> 6) * 256 + hd * 64 + (id & 63)]; av_[i] = a_up[(id >> 6) * 256 + hd * 64 + (id & 63)]; }
#pragma unroll
          for (int i = 0; i < 4; ++i) { wlds[tid + 512 * i] = wv_[i]; alds[tid + 512 * i] = av_[i]; } }
        const float mu_r = mu[ch], mu_k = mu[256 + ch], mu_v = mu[512 + ch], mu_l = mu[1024 + lane];
        const bf16* hp = H + (row0 + 8 * w) * HLD + C_R0;
        float pr = 0.f, pk = 0.f, pv = 0.f, pl = 0.f;
        if (c != 0 || w != 0) { const bf16* q = hp - HLD; pr = bf2f(q[ch]); pk = bf2f(q[256 + ch]); pv = bf2f(q[512 + ch]); pl = bf2f(q[1024 + lane]); }
#pragma unroll
        for (int i = 0; i < 8; ++i) { const bf16* q = hp + (size_t)i * HLD; const float cr = bf2f(q[ch]), ck = bf2f(q[256 + ch]), cv = bf2f(q[512 + ch]), cl = bf2f(q[1024 + lane]);
            rr[i] = cr + (pr - cr) * mu_r; k2[i] = ck + (pk - ck) * mu_k; vv[i] = cv + (pv - cv) * mu_v; const float l_ = cl + (pl - cl) * mu_l;
            lo[lane * 64 + 8 * w + i] = (lane < 32) ? tanhf(l_) : l_;
            pr = cr; pk = ck; pv = cv; pl = cl; }
    }
    __syncthreads();
    RELANE();
    {
        float dd[8], aa[8];
        { const float w0c = w0[ch], a0c = a0[ch];
#pragma unroll
          for (int i = 0; i < 8; ++i) { dd[i] = w0c; aa[i] = a0c; } }
#pragma unroll 4
        for (int j = 0; j < 32; ++j) {
            const float wuj = wlds[j * 64 + lane], auj = alds[j * 64 + lane];
            const f32x4 x0 = *(const LAS f32x4*)(lo + j * 64 + 8 * w), x1 = *(const LAS f32x4*)(lo + j * 64 + 8 * w + 4);
            const f32x4 y0 = *(const LAS f32x4*)(lo + (32 + j) * 64 + 8 * w), y1 = *(const LAS f32x4*)(lo + (32 + j) * 64 + 8 * w + 4);
#pragma unroll
            for (int i = 0; i < 4; ++i) { dd[i] += x0[i] * wuj; dd[4 + i] += x1[i] * wuj; aa[i] += y0[i] * auj; aa[4 + i] += y1[i] * auj; }
        }
        const float kkc = k_k[ch], kac = k_a[ch], rkc = r_k[ch];
#pragma unroll
        for (int i = 0; i < 8; ++i) {
            const float asig = sigmoid_f(aa[i]); lw[i] = -RW_LOGC * sigmoid_f(dd[i]);
            float kk = k2[i] * kkc; const float n2 = wave_sum(kk * kk); kk = kk / fmaxf(sqrtf(n2), 1e-12f);
            k2[i] = k2[i] * (1.f + (asig - 1.f) * kac);
            const float bonus = wave_sum(rr[i] * k2[i] * rkc);
            if (lane == 0) BON[(row0 + 8 * w + i) * 4 + hd] = bonus;
            av[i] = -kk; bv[i] = kk * asig;
        }
    }
    RELANE();
    float cum[8];
    { float a = 0.f;
#pragma unroll
      for (int i = 0; i < 8; ++i) { a += lw[i]; cum[i] = a; }
      tot[w * 64 + lane] = a; }
    __syncthreads();
    { float off = 0.f, all = 0.f;
#pragma unroll
      for (int j = 0; j < 8; ++j) { const float t_ = tot[j * 64 + lane]; all += t_; if (j < w) off += t_; }
#pragma unroll
      for (int i = 0; i < 8; ++i) cum[i] += off;
      const float gc = __expf(all);
      if (w == 0) { gcs[lane] = gc; GC[(size_t)ci * 64 + lane] = gc; } }
    RELANE();
    {
        float ta[8], tb[8], tk[8], tr[8];
#pragma unroll
        for (int i = 0; i < 8; ++i) { const float ep = __expf(cum[i]), en = __expf(-cum[i]), epv = __expf(cum[i] - lw[i]);
            ta[i] = av[i] * epv; tb[i] = bv[i] * en; tk[i] = k2[i] * en; tr[i] = rr[i] * ep;
            const int o = (8 * w + i) * TP + lane; At[o] = f2bf(ta[i]); Bt[o] = f2bf(tb[i]); Kt[o] = f2bf(tk[i]); Rt[o] = f2bf(tr[i]); }
        const int ot = lane * TP + 8 * w;
        *(LAS u32x4*)(AtT + ot) = (u32x4){pk_bf16(ta[0], ta[1]), pk_bf16(ta[2], ta[3]), pk_bf16(ta[4], ta[5]), pk_bf16(ta[6], ta[7])};
        *(LAS u32x4*)(BtT + ot) = (u32x4){pk_bf16(tb[0], tb[1]), pk_bf16(tb[2], tb[3]), pk_bf16(tb[4], tb[5]), pk_bf16(tb[6], tb[7])};
        *(LAS u32x4*)(KtT + ot) = (u32x4){pk_bf16(tk[0], tk[1]), pk_bf16(tk[2], tk[3]), pk_bf16(tk[4], tk[5]), pk_bf16(tk[6], tk[7])};
        *(LAS u32x4*)(VT + ot) = (u32x4){pk_bf16(vv[0], vv[1]), pk_bf16(vv[2], vv[3]), pk_bf16(vv[4], vv[5]), pk_bf16(vv[6], vv[7])};
    }
    __syncthreads();
    RELANE();
    const int mt = w & 3; const bool lowh = (w < 4);
    f32x4 x[4], y[4];
    ZERO4(x); ZERO4(y);
    if (lowh) { mm_row4(x, At, Bt, mt, fr, g); mm_row4(y, At, Kt, mt, fr, g); }
    else      { mm_row4(x, Rt, Bt, mt, fr, g); mm_row4(y, Rt, Kt, mt, fr, g); }
#pragma unroll
    for (int n = 0; n < 4; ++n)
#pragma unroll
        for (int r = 0; r < 4; ++r) { const int row = 16 * mt + 4 * g + r, col = 16 * n + fr; const bool keep = lowh ? (col < row) : (col <= row); if (!keep) { x[n][r] = 0.f; y[n][r] = 0.f; } }
    f32x4 tacc[4];
    ZERO4(tacc);
    if (lowh) { wr_nat4(Pn, x, mt, fr, g); wr_tr4(PT, x, mt, fr, g); wr_nat4(Aak, y, mt, fr, g);
#pragma unroll
        for (int n = 0; n < 4; ++n)
#pragma unroll
            for (int r = 0; r < 4; ++r) if (16 * mt + 4 * g + r == 16 * n + fr) x[n][r] += 1.f;
        wr_nat4(Tn, x, mt, fr, g); wr_tr4(TT, x, mt, fr, g); }
    else { wr_nat4(Arb, x, mt, fr, g); wr_nat4(Ark, y, mt, fr, g); }
    __syncthreads();
    RELANE();
    if (!lowh) {
#pragma unroll
        for (int n = 0; n < 4; ++n)
#pragma unroll
            for (int r = 0; r < 4; ++r) tacc[n][r] = bf2f(Tn[(16 * mt + 4 * g + r) * TP + n * 16 + fr]);
    }
#pragma unroll 1
    for (int p = 1; p <= 6; ++p) {
        RELANE();
        ZERO4(x);
        if (lowh) { if (p <= 5) mm_row4(x, Pn, PT, mt, fr, g); }
        else if (p >= 2) mm_row4(tacc, Pn, TT, mt, fr, g);
        __syncthreads();
        if (lowh) { if (p <= 5) { wr_nat4(Pn, x, mt, fr, g); wr_tr4(PT, x, mt, fr, g); } }
        else if (p >= 2) { wr_nat4(Tn, tacc, mt, fr, g); if (p <= 5) wr_tr4(TT, tacc, mt, fr, g); }
        __syncthreads();
    }
    RELANE();
    ZERO4(x);
    if (lowh) { mm_row4(x, Tn, AtT, mt, fr, g); wr_tr4(WtT, x, mt, fr, g); }
    else      { mm_row4(x, Aak, VT, mt, fr, g); wr_tr4(X1T, x, mt, fr, g); }
    __syncthreads();
    RELANE();
    ZERO4(x); ZERO4(y);
    if (lowh) { mm_row4(x, Tn, X1T, mt, fr, g); wr_tr4(UtT, x, mt, fr, g); }
    else {
        mm_row4(x, Arb, WtT, mt, fr, g);
#pragma unroll
        for (int n = 0; n < 4; ++n)
#pragma unroll
            for (int r = 0; r < 4; ++r) { const int row = 16 * mt + 4 * g + r, col = 16 * n + fr; const int pc = ((col >> 2) & 1) * 32 + (col >> 5) * 16 + ((col >> 3) & 3) * 4 + (col & 3);
                GQ[(size_t)ci * 4096 + row * 64 + pc] = f2bf(x[n][r] + bf2f(Rt[row * TP + col])); }
        mm_row4(y, WtT, BtT, mt, fr, g);
#pragma unroll
        for (int n = 0; n < 4; ++n) { const int j = 16 * n + fr; const float gc = gcs[j];
            *(u32x2*)(GGP + (size_t)ci * 4096 + j * 64 + mt * 16 + (g & 1) * 8 + (g >> 1) * 4) = (u32x2){pk_bf16(y[n][0] * gc, y[n][1] * gc), pk_bf16(y[n][2] * gc, y[n][3] * gc)}; }
    }
    __syncthreads();
    RELANE();
    ZERO4(x);
    if (lowh) { mm_row4(x, Arb, UtT, mt, fr, g); mm_row4(x, Ark, VT, mt, fr, g);
#pragma unroll
        for (int n = 0; n < 4; ++n)
#pragma unroll
            for (int r = 0; r < 4; ++r) GYL[(size_t)ci * 4096 + (16 * mt + 4 * g + r) * 64 + 16 * n + fr] = f2bf(x[n][r]);
    } else { mm_row4(x, UtT, BtT, mt, fr, g); mm_row4(x, VT, KtT, mt, fr, g);
#pragma unroll
        for (int n = 0; n < 4; ++n) { const int j = 16 * n + fr; const float gc = gcs[j];
#pragma unroll
            for (int r = 0; r < 4; ++r) GHC[(size_t)ci * 4096 + (16 * mt + 4 * g + r) * 64 + j] = f2bf(x[n][r] * gc); }
    }
    __syncthreads();
#undef TILE
#undef RELANE
}
__device__ __forceinline__ void ph_rwkv_b(const bf16* H, const float* mu, const float* w_up, const float* w0, const float* a_up, const float* a0, const float* k_k, const float* k_a, const float* r_k,
                                          bf16* GQ, bf16* GYL, bf16* GGP, bf16* GHC, float* GC, float* BON) {
    int tid = threadIdx.x; asm volatile("" : "+v"(tid)); LAUNDER_BG();
    for (int ci = bx_; ci < 2048; ci += gx_) rwkv_b_item(ci, tid, H, mu, w_up, w0, a_up, a0, k_k, k_a, r_k, GQ, GYL, GGP, GHC, GC, BON);
}
constexpr int SR_G = 0, SR_H = 9216, SR_C = 9216 + 64 * 136, SR_STEP = SR_C + 256, SR_GRP = 2 * SR_STEP, SR_NBUF = 4, SR_FLAGS = SR_NBUF * SR_GRP;
static_assert(SR_FLAGS + 256 <= 147456 - 64, "scan ring");
__device__ __forceinline__ unsigned lds_ld(volatile LAS unsigned* p) { return *p; }
__device__ __forceinline__ void ph_rwkv_scan_fast(int bh, const bf16* GGP, const bf16* GHC, const float* GC, bf16* GS2) {
    int tid = threadIdx.x; asm volatile("" : "+v"(tid)); bh = __builtin_amdgcn_readfirstlane(bh); asm volatile("" : "+s"(bh));
    LAS unsigned char* L = (LAS unsigned char*)dyn_lds; volatile LAS unsigned* full = (volatile LAS unsigned*)(L + SR_FLAGS); volatile LAS unsigned* empty = full + 8;
    const int w = __builtin_amdgcn_readfirstlane(tid >> 6), lane = tid & 63;
    if (tid < 64) full[tid] = 0u;
    __syncthreads();
    if (w >= 2) {
#pragma unroll 1
        for (int g = w - 2; g < 128; g += 6) {
            const size_t ci0 = (size_t)bh * 256 + 2 * g; const int l5 = lane & 31;
            const unsigned char* g0 = (const unsigned char*)(GGP + ci0 * 4096) + lane * 16; const unsigned char* h0 = (const unsigned char*)(GHC + ci0 * 4096) + lane * 16;
            u32x4 R[33];
#pragma unroll
            for (int it = 0; it < 8; ++it) { R[it] = *(const u32x4*)(g0 + 1024 * it); R[8 + it] = *(const u32x4*)(h0 + 1024 * it); R[16 + it] = *(const u32x4*)(g0 + 8192 + 1024 * it); R[24 + it] = *(const u32x4*)(h0 + 8192 + 1024 * it); }
            R[32] = *(const u32x4*)((const unsigned char*)(GC + (ci0 + (l5 >> 4)) * 64) + (l5 & 15) * 16);
            const int buf = g & (SR_NBUF - 1);
            if (g >= SR_NBUF) { const unsigned need = (unsigned)(g / SR_NBUF); while (lds_ld(empty + 2 * buf) < need || lds_ld(empty + 2 * buf + 1) < need) __builtin_amdgcn_s_sleep(1); }
            LAS unsigned char* d0 = L + buf * SR_GRP;
#pragma unroll
            for (int it = 0; it < 8; ++it) { const int row = (lane >> 3) + 8 * it, ch = lane & 7;
                *(LAS u32x4*)(d0 + SR_G + row * 144 + ch * 16) = R[it]; *(LAS u32x4*)(d0 + SR_STEP + SR_G + row * 144 + ch * 16) = R[16 + it];
                LAS unsigned char* q0 = d0 + SR_H + row * 136 + ch * 16; *(LAS u32x2*)q0 = (u32x2){R[8 + it][0], R[8 + it][1]}; *(LAS u32x2*)(q0 + 8) = (u32x2){R[8 + it][2], R[8 + it][3]};
                LAS unsigned char* q1 = q0 + SR_STEP; *(LAS u32x2*)q1 = (u32x2){R[24 + it][0], R[24 + it][1]}; *(LAS u32x2*)(q1 + 8) = (u32x2){R[24 + it][2], R[24 + it][3]}; }
            if (lane < 32) *(LAS u32x4*)(d0 + (l5 >> 4) * SR_STEP + SR_C + (l5 & 15) * 16) = R[32];
            asm volatile("s_waitcnt lgkmcnt(0)" ::: "memory");
            if (lane == 0) full[buf] = (unsigned)(g / SR_NBUF) + 1u;
        }
    } else {
        const int l31 = lane & 31, h = lane >> 5, v = w * 32 + l31;
        f32x16 X[2];
#pragma unroll
        for (int r = 0; r < 16; ++r) { X[0][r] = 0.f; X[1][r] = 0.f; }
        for (int g = 0; g < 128; ++g) {
            const int buf = g & (SR_NBUF - 1);
            { const unsigned need = (unsigned)(g / SR_NBUF + 1); while (lds_ld(full + buf) < need) __builtin_amdgcn_s_sleep(0); }
            asm volatile("" ::: "memory");
#pragma unroll
            for (int st = 0; st < 2; ++st) {
                const LAS unsigned char* d = L + buf * SR_GRP + st * SR_STEP; const size_t ci = (size_t)bh * 256 + 2 * g + st;
                bf16* sp = GS2 + ci * 4096 + v * 64 + 32 * h;
                bf16x8 af[2][4]; u32x2 hv[2][4]; f32x4 gv[2][4];
#pragma unroll
                for (int kt = 0; kt < 2; ++kt)
#pragma unroll
                    for (int q = 0; q < 4; ++q) { af[kt][q] = *(const LAS bf16x8*)(d + SR_G + (32 * kt + l31) * 144 + q * 32 + h * 16);
                        hv[kt][q] = *(const LAS u32x2*)(d + SR_H + v * 136 + (32 * kt + 8 * q + 4 * h) * 2); gv[kt][q] = *(const LAS f32x4*)(d + SR_C + (32 * kt + 8 * q + 4 * h) * 4); }
                unsigned bw[2][8];
#pragma unroll
                for (int kt = 0; kt < 2; ++kt)
#pragma unroll
                    for (int q = 0; q < 4; ++q) { bw[kt][2 * q] = pk_bf16(X[kt][4 * q], X[kt][4 * q + 1]); bw[kt][2 * q + 1] = pk_bf16(X[kt][4 * q + 2], X[kt][4 * q + 3]); }
#pragma unroll
                for (int kt = 0; kt < 2; ++kt) { *(u32x4*)(sp + 16 * kt) = (u32x4){bw[kt][0], bw[kt][1], bw[kt][2], bw[kt][3]}; *(u32x4*)(sp + 16 * kt + 8) = (u32x4){bw[kt][4], bw[kt][5], bw[kt][6], bw[kt][7]}; }
                f32x16 Xn[2];
#pragma unroll
                for (int kt = 0; kt < 2; ++kt)
#pragma unroll
                    for (int q = 0; q < 4; ++q) { Xn[kt][4 * q + 0] = gv[kt][q][0] * X[kt][4 * q + 0] + bflo(hv[kt][q][0]); Xn[kt][4 * q + 1] = gv[kt][q][1] * X[kt][4 * q + 1] + bfhi(hv[kt][q][0]);
                                                 Xn[kt][4 * q + 2] = gv[kt][q][2] * X[kt][4 * q + 2] + bflo(hv[kt][q][1]); Xn[kt][4 * q + 3] = gv[kt][q][3] * X[kt][4 * q + 3] + bfhi(hv[kt][q][1]); }
#pragma unroll
                for (int kt = 0; kt < 2; ++kt)
#pragma unroll
                    for (int ks = 0; ks < 4; ++ks) { const u32x4 bq = (u32x4){bw[ks >> 1][4 * (ks & 1)], bw[ks >> 1][4 * (ks & 1) + 1], bw[ks >> 1][4 * (ks & 1) + 2], bw[ks >> 1][4 * (ks & 1) + 3]};
                        Xn[kt] = __builtin_amdgcn_mfma_f32_32x32x16_bf16(af[kt][ks], __builtin_bit_cast(bf16x8, bq), Xn[kt], 0, 0, 0); }
                X[0] = Xn[0]; X[1] = Xn[1];
            }
            asm volatile("s_waitcnt lgkmcnt(0)" ::: "memory");
            if (lane == 0) empty[2 * buf + w] = (unsigned)(g / SR_NBUF) + 1u;
        }
    }
}
__device__ __forceinline__ void rwkv_d_item(const Team& T, int ci, const bf16* H, const float* mu, const bf16* GQ, const bf16* GYL, const bf16* GS2, const float* BON, const float* gn_w, const float* gn_b, bf16* O) {
    const int c = ci & 255, hd = (ci >> 8) & 3, b = ci >> 10; const size_t row0 = (size_t)b * SEQ + c * 64;
    LAS bf16* QT = (LAS bf16*)T.lds; LAS bf16* ST = QT + 64 * TP;
    { const int s = T.ttid >> 2, c0 = (T.ttid & 3) * 16; const uint4* qp = (const uint4*)(GQ + (size_t)ci * 4096 + s * 64 + c0); const uint4* sp = (const uint4*)(GS2 + (size_t)ci * 4096 + s * 64 + c0);
      const uint4 q0 = qp[0], q1 = qp[1], s0 = sp[0], s1 = sp[1];
      *(LAS u32x4*)(QT + s * TP + c0) = (u32x4){q0.x, q0.y, q0.z, q0.w}; *(LAS u32x4*)(QT + s * TP + c0 + 8) = (u32x4){q1.x, q1.y, q1.z, q1.w};
      *(LAS u32x4*)(ST + s * TP + c0) = (u32x4){s0.x, s0.y, s0.z, s0.w}; *(LAS u32x4*)(ST + s * TP + c0 + 8) = (u32x4){s1.x, s1.y, s1.z, s1.w}; }
    __syncthreads();
    f32x4 y[4]; ZERO4(y);
    mm_row4(y, QT, ST, T.tw, T.fr, T.g);
#pragma unroll
    for (int r = 0; r < 4; ++r) {
        const int t = 16 * T.tw + 4 * T.g + r; const size_t row = row0 + t;
        float yv[4], sm = 0.f;
#pragma unroll
        for (int n = 0; n < 4; ++n) { yv[n] = y[n][r] + bf2f(GYL[(size_t)ci * 4096 + t * 64 + n * 16 + T.fr]); sm += yv[n]; }
        sm += __shfl_xor(sm, 1); sm += __shfl_xor(sm, 2); sm += __shfl_xor(sm, 4); sm += __shfl_xor(sm, 8);
        const float mean = sm * (1.f / 64.f); float sq = 0.f;
#pragma unroll
        for (int n = 0; n < 4; ++n) { yv[n] -= mean; sq += yv[n] * yv[n]; }
        sq += __shfl_xor(sq, 1); sq += __shfl_xor(sq, 2); sq += __shfl_xor(sq, 4); sq += __shfl_xor(sq, 8);
        const float rs = rsqrtf(sq * (1.f / 64.f) + 64e-5f), bon = BON[row * 4 + hd];
#pragma unroll
        for (int n = 0; n < 4; ++n) { const int chn = hd * 64 + n * 16 + T.fr;
            float o = yv[n] * rs * gn_w[chn] + gn_b[chn];
            o += bon * tshift(H, (int)row, C_R0 + 512 + chn, mu[512 + chn]);
            const float gt = tshift(H, (int)row, C_R0 + 768 + chn, mu[768 + chn]);
            O[row * DM + 768 + chn] = f2bf(o * silu_f(gt)); }
    }
    __syncthreads();
}
__device__ __forceinline__ void ph_rwkv_d(const bf16* H, const float* mu, const bf16* GQ, const bf16* GYL, const bf16* GS2, const float* BON, const float* gn_w, const float* gn_b, bf16* O) {
    MKTEAM();
    for (int ci = T.gteam; ci < 2048; ci += T.nteams) rwkv_d_item(T, ci, H, mu, GQ, GYL, GS2, BON, gn_w, gn_b, O);
}

__device__ __forceinline__ void ph_rwkv_pre(const bf16* H, const float* mu, const float* w_up, const float* w0, const float* a_up, const float* a0,
                                            const float* k_k, const float* k_a, const float* r_k, float* RW, bf16* RK, bf16* RA, bf16* RB, float* BON) {
    MKCTX();
    const int ch = c.vtid; LAS float* lo = (LAS float*)(c.lds + c.half * 65536);
    const int iters = (MTOK + c.nvb - 1) / c.nvb;
    for (int it = 0; it < iters; ++it) {
        const int t = it * c.nvb + c.vb; const bool act = t < MTOK;
        HALF_BAR();
        if (act) { if (ch < 32) lo[ch] = tanhf(tshift(H, t, C_R0 + 1024 + ch, mu[1024 + ch])); else if (ch < 64) lo[ch] = tshift(H, t, C_R0 + 1024 + ch, mu[1024 + ch]); }
        HALF_BAR();
        if (act) {
            const float r = tshift(H, t, C_R0 + ch, mu[ch]), k = tshift(H, t, C_R0 + 256 + ch, mu[256 + ch]);
            float d = w0[ch], aa = a0[ch];
#pragma unroll 8
            for (int j = 0; j < 32; ++j) { d += lo[j] * w_up[j * 256 + ch]; aa += lo[32 + j] * a_up[j * 256 + ch]; }
            const float a = sigmoid_f(aa), decay = expf(-0.6065306597126334f * sigmoid_f(d));
            float kk = k * k_k[ch]; const float n2 = wave_sum(kk * kk); kk = kk / fmaxf(sqrtf(n2), 1e-12f);
            const float k2 = k * (1.f + (a - 1.f) * k_a[ch]);
            const float bonus = wave_sum(r * k2 * r_k[ch]);
            const size_t o = (size_t)t * 256 + ch;
            RW[o] = decay; RK[o] = f2bf(k2); RA[o] = f2bf(-kk); RB[o] = f2bf(kk * a);
            if ((ch & 63) == 0) BON[(size_t)t * 4 + (ch >> 6)] = bonus;
        }
    }
}
__device__ __forceinline__ void ph_rwkv_scan(const bf16* H, const float* mu, const float* RW, const bf16* RK, const bf16* RA, const bf16* RB, float* RY) {
    MKCTX(); const int sb = c.vb - 16;
    const int b = sb >> 2, hd = sb & 3, tid = c.vtid, lane = tid & 63, v = (tid >> 6) * 16 + (lane >> 2), kq = lane & 3;
    LAS float* base = (LAS float*)(c.lds + c.half * 65536);
    LAS float* sr = base; LAS float* sw = base + 2048; LAS float* sk = base + 4096; LAS float* sv = base + 6144; LAS float* sa = base + 8192; LAS float* sbb = base + 10240;
    float s[16];
#pragma unroll
    for (int i = 0; i < 16; ++i) s[i] = 0.f;
    for (int t0 = 0; t0 < SEQ; t0 += 32) {
        HALF_BAR();
        for (int i = tid; i < 2048; i += 256) { const int tt = i >> 6, ch = i & 63; const int row = b * SEQ + t0 + tt; const size_t o = (size_t)row * 256 + hd * 64 + ch;
            sr[i] = bf2f(f2bf(tshift(H, row, C_R0 + hd * 64 + ch, mu[hd * 64 + ch]))); sv[i] = bf2f(f2bf(tshift(H, row, C_R0 + 512 + hd * 64 + ch, mu[512 + hd * 64 + ch])));
            sw[i] = RW[o]; sk[i] = bf2f(RK[o]); sa[i] = bf2f(RA[o]); sbb[i] = bf2f(RB[o]); }
        HALF_BAR();
        for (int tt = 0; tt < 32; ++tt) {
            float sA = 0.f;
#pragma unroll
            for (int i = 0; i < 16; ++i) sA += s[i] * sa[tt * 64 + kq * 16 + i];
            sA += __shfl_xor(sA, 1); sA += __shfl_xor(sA, 2);
            const float vv = sv[tt * 64 + v]; float y = 0.f;
#pragma unroll
            for (int i = 0; i < 16; ++i) { const int k = tt * 64 + kq * 16 + i; s[i] = s[i] * sw[k] + sA * sbb[k] + vv * sk[k]; y += s[i] * sr[k]; }
            y += __shfl_xor(y, 1); y += __shfl_xor(y, 2);
            if (kq == 0) RY[((size_t)b * SEQ + t0 + tt) * 256 + hd * 64 + v] = y;
        }
    }
}
__device__ __forceinline__ void ph_rwkv_post(const bf16* H, const float* mu, const float* RY, const float* BON, const float* gn_w, const float* gn_b, bf16* O) {
    MKCTX();
    const int ch = c.vtid;
    for (int t = c.vb; t < MTOK; t += c.nvb) {
        const float y = RY[(size_t)t * 256 + ch]; const float mean = wave_sum(y) * (1.f / 64.f); const float dl = y - mean; const float var = wave_sum(dl * dl) * (1.f / 64.f);
        float yn = dl * rsqrtf(var + 64e-5f) * gn_w[ch] + gn_b[ch];
        yn += BON[(size_t)t * 4 + (ch >> 6)] * tshift(H, t, C_R0 + 512 + ch, mu[512 + ch]);
        const float g = tshift(H, t, C_R0 + 768 + ch, mu[768 + ch]);
        O[(size_t)t * DM + 768 + ch] = f2bf(yn * silu_f(g));
    }
}
__device__ __forceinline__ void ph_moba_kbar(const bf16* H, float* KB) {
    MKCTX();
    LAS float* red = (LAS float*)(c.lds + c.half * 65536); const int tid = c.vtid, d = tid & 63, part = tid >> 6;
    const int iters = (BATCH * 8 * 64 + c.nvb - 1) / c.nvb;
    for (int it = 0; it < iters; ++it) {
        const int bid = it * c.nvb + c.vb; const bool act = bid < BATCH * 8 * 64; const int n = bid & 63, h = (bid >> 6) & 7, b = bid >> 9;
        float s = 0.f;
        if (act) for (int tt = 0; tt < 64; ++tt) s += bf2f(H[((size_t)b * SEQ + n * 256 + part * 64 + tt) * NPAD + C_MK + h * 64 + d]);
        HALF_BAR();
        red[part * 64 + d] = s;
        HALF_BAR();
        if (act && part == 0) KB[(size_t)bid * 64 + d] = (red[d] + red[64 + d] + red[128 + d] + red[192 + d]) * (1.f / 256.f);
    }
}

__device__ __forceinline__ int t5_bucket(int rel) {
    if (rel < 16) return rel;
    const int m = 31 - __clz(rel);
    int bkt = 16 + 2 * (m - 4) + (((unsigned)rel * (unsigned)rel >= (2u << (2 * m))) ? 1 : 0);
    return bkt > 31 ? 31 : bkt;
}
constexpr int KP = 72, VP = 260;
constexpr int MB_K = 0, MB_V = 256 * KP * 2, MB_BT = MB_V + 64 * VP * 2, MB_PFX = MB_BT + 16384 * 4, MB_END = MB_PFX + 1040 * 4;
static_assert(MB_END <= 147456, "MoBA LDS map");
constexpr float SC2 = 0.18033688011112042f, LOG2E = 1.4426950408889634f;
constexpr int LIST_PER_BH = 516096;
__device__ __forceinline__ int list_off(int bh, int n) { return bh * LIST_PER_BH + 16384 * n - 128 * n * (n + 1); }
__device__ __forceinline__ void ph_moba_kbar2(const bf16* H, bf16* KBH, bf16* KBL) {
    MKCTX();
    LAS float* red = (LAS float*)(c.lds + c.half * 65536); const int tid = c.vtid, d = tid & 63, part = tid >> 6;
    const int iters = (BATCH * 8 * 64 + c.nvb - 1) / c.nvb;
    for (int it = 0; it < iters; ++it) {
        const int bid = it * c.nvb + c.vb; const bool act = bid < BATCH * 8 * 64; const int n = bid & 63, h = (bid >> 6) & 7, b = bid >> 9;
        float s = 0.f;
        if (act) for (int tt = 0; tt < 64; ++tt) s += bf2f(H[((size_t)b * SEQ + n * 256 + part * 64 + tt) * HLD + C_MK + h * 64 + d]);
        HALF_BAR();
        red[part * 64 + d] = s;
        HALF_BAR();
        if (act && part == 0) { const float m = (red[d] + red[64 + d] + red[128 + d] + red[192 + d]) * (1.f / 256.f); const bf16 hi = f2bf(m);
            KBH[(size_t)((b * 8 + h) * 64 + n) * 64 + d] = hi; KBL[(size_t)((b * 8 + h) * 64 + n) * 64 + d] = f2bf(m - bf2f(hi)); }
    }
}
__device__ __forceinline__ unsigned gate_key(float v, int n) {
    const unsigned u = __float_as_uint(v); const unsigned o = (u & 0x80000000u) ? ~u : (u | 0x80000000u);
    return (o & ~63u) | (unsigned)(63 - n);
}
#define TOP3_INS(x_) do { unsigned x1_ = (x_); const unsigned a_ = max(k1, x1_); x1_ = min(k1, x1_); const unsigned b_ = max(k2, x1_); x1_ = min(k2, x1_); k1 = a_; k2 = b_; k3 = max(k3, x1_); } while (0)
__device__ __forceinline__ void ph_moba_gate(const bf16* H, const bf16* KBH, const bf16* KBL, unsigned* CNT, unsigned short* LIST, unsigned* SEL) {
    int tid = threadIdx.x; asm volatile("" : "+v"(tid));
    const int lane = tid & 63, l31 = lane & 31, hh = lane >> 5, wv = __builtin_amdgcn_readfirstlane(tid >> 6); LAUNDER_BG(); const int gw0 = bx_ * 8 + wv, ngw = gx_ * 8;
    LAS unsigned* hist = (LAS unsigned*)((LAS unsigned char*)dyn_lds + wv * 512); LAS unsigned* base = hist + 64;
    for (int task = gw0; task < 16 * 128; task += ngw) {
        const int bh = task >> 7, t128 = task & 127, b = bh >> 3, h = bh & 7, own = t128 >> 1;
        if (own == 0) continue;
        hist[lane] = 0u;
        unsigned pk[4][3];
#pragma unroll
        for (int i = 0; i < 4; ++i) {
            const int t = t128 * 128 + i * 32 + l31;
            const bf16* qrow = H + ((size_t)b * SEQ + t) * HLD + C_MQ + h * 64 + hh * 8;
            bf16x8 qf[4];
#pragma unroll
            for (int ks = 0; ks < 4; ++ks) qf[ks] = *(const bf16x8*)(qrow + 16 * ks);
            f32x16 gsc[2];
#pragma unroll
            for (int nt = 0; nt < 2; ++nt) {
#pragma unroll
                for (int r = 0; r < 16; ++r) gsc[nt][r] = 0.f;
                if (32 * nt < own) {
                    const bf16* kh = KBH + ((size_t)bh * 64 + 32 * nt + l31) * 64 + hh * 8; const bf16* kl = KBL + ((size_t)bh * 64 + 32 * nt + l31) * 64 + hh * 8;
#pragma unroll
                    for (int ks = 0; ks < 4; ++ks) { gsc[nt] = __builtin_amdgcn_mfma_f32_32x32x16_bf16(*(const bf16x8*)(kh + 16 * ks), qf[ks], gsc[nt], 0, 0, 0);
                                                     gsc[nt] = __builtin_amdgcn_mfma_f32_32x32x16_bf16(*(const bf16x8*)(kl + 16 * ks), qf[ks], gsc[nt], 0, 0, 0); }
                }
            }
            unsigned k1 = 0u, k2 = 0u, k3 = 0u;
#pragma unroll
            for (int nt = 0; nt < 2; ++nt)
#pragma unroll
                for (int r = 0; r < 16; ++r) { const int n = 32 * nt + (r & 3) + 8 * (r >> 2) + 4 * hh; const unsigned key = (n < own) ? gate_key(gsc[nt][r], n) : 0u; TOP3_INS(key); }
            { const unsigned p1 = __shfl_xor(k1, 32), p2 = __shfl_xor(k2, 32), p3 = __shfl_xor(k3, 32); TOP3_INS(p1); TOP3_INS(p2); TOP3_INS(p3); }
            const unsigned ks3[3] = {k1, k2, k3};
#ifdef MOBA_CHECK
            if (hh == 0) SEL[(size_t)bh * SEQ + t] = (63u - (k1 & 63u)) | ((63u - (k2 & 63u)) << 8) | ((63u - (k3 & 63u)) << 16);
#endif
#pragma unroll
            for (int j = 0; j < 3; ++j) { pk[i][j] = 0u;
                if (hh == 0 && j < own) { const unsigned n = 63u - (ks3[j] & 63u); const unsigned rk = __hip_atomic_fetch_add(&hist[n], 1u, __ATOMIC_RELAXED, __HIP_MEMORY_SCOPE_WORKGROUP); pk[i][j] = n | (rk << 8); } }
        }
        { const unsigned cn = hist[lane]; base[lane] = cn ? atomicAdd(&CNT[bh * 64 + lane], cn) : 0u; }
#pragma unroll
        for (int i = 0; i < 4; ++i)
#pragma unroll
            for (int j = 0; j < 3; ++j) if (hh == 0 && j < own) { const unsigned n = pk[i][j] & 0xffu, rk = pk[i][j] >> 8; const int t = t128 * 128 + i * 32 + l31;
                LIST[(size_t)list_off(bh, (int)n) + base[n] + rk] = (unsigned short)((t << 2) | j); }
    }
}
__device__ __forceinline__ void moba_stage(LAS unsigned char* L, int tid, const bf16* H, const float* rel_bias, int b, int h, int n, int nrel) {
    LAS bf16* Kt = (LAS bf16*)(L + MB_K); LAS bf16* Vt = (LAS bf16*)(L + MB_V); LAS float* bt = (LAS float*)(L + MB_BT);
#pragma unroll
    for (int i = 0; i < 4; ++i) { const int id = tid + 512 * i, row = id >> 3, ch = id & 7; const bf16* src = H + ((size_t)b * SEQ + n * 256 + row) * HLD + h * 64 + ch * 8;
        const uint4 kv = *(const uint4*)(src + C_MK), vv = *(const uint4*)(src + C_MV);
        *(LAS u32x4*)(Kt + row * KP + ch * 8) = (u32x4){kv.x, kv.y, kv.z, kv.w};
        LAS bf16* vd = Vt + (ch * 8) * VP + row;
        vd[0] = (bf16)(vv.x & 0xffffu); vd[VP] = (bf16)(vv.x >> 16); vd[2 * VP] = (bf16)(vv.y & 0xffffu); vd[3 * VP] = (bf16)(vv.y >> 16);
        vd[4 * VP] = (bf16)(vv.z & 0xffffu); vd[5 * VP] = (bf16)(vv.z >> 16); vd[6 * VP] = (bf16)(vv.w & 0xffffu); vd[7 * VP] = (bf16)(vv.w >> 16); }
    for (int rel = tid; rel < nrel; rel += 512) bt[rel] = rel_bias[t5_bucket(rel) * 8 + h] * LOG2E;
}
#define MOBA_QK(kt_) do { s[kt_] = (f32x16){0.f,0.f,0.f,0.f,0.f,0.f,0.f,0.f,0.f,0.f,0.f,0.f,0.f,0.f,0.f,0.f}; _Pragma("unroll") for (int ks = 0; ks < 4; ++ks) \
    s[kt_] = __builtin_amdgcn_mfma_f32_32x32x16_bf16(*(const LAS bf16x8*)(Kt + (32 * (kt_) + l31) * KP + 16 * ks + 8 * hh), qf[ks], s[kt_], 0, 0, 0); } while (0)
#define MOBA_PV(kt_) do { _Pragma("unroll") for (int sp = 0; sp < 2; ++sp) { \
    const u32x4 pa = (u32x4){pk_bf16(s[kt_][8 * sp], s[kt_][8 * sp + 1]), pk_bf16(s[kt_][8 * sp + 2], s[kt_][8 * sp + 3]), pk_bf16(s[kt_][8 * sp + 4], s[kt_][8 * sp + 5]), pk_bf16(s[kt_][8 * sp + 6], s[kt_][8 * sp + 7])}; \
    _Pragma("unroll") for (int dt = 0; dt < 2; ++dt) { const LAS bf16* vp = Vt + (32 * dt + l31) * VP + 32 * (kt_) + 16 * sp + 4 * hh; const u32x2 v0 = *(const LAS u32x2*)vp, v1 = *(const LAS u32x2*)(vp + 8); \
        o[dt] = __builtin_amdgcn_mfma_f32_32x32x16_bf16(__builtin_bit_cast(bf16x8, pa), __builtin_bit_cast(bf16x8, ((u32x4){v0[0], v0[1], v1[0], v1[1]})), o[dt], 0, 0, 0); } } } while (0)
#define MOBA_QK2(si_, kt_) do { s[si_] = (f32x16){0.f,0.f,0.f,0.f,0.f,0.f,0.f,0.f,0.f,0.f,0.f,0.f,0.f,0.f,0.f,0.f}; _Pragma("unroll") for (int ks = 0; ks < 4; ++ks) \
    s[si_] = __builtin_amdgcn_mfma_f32_32x32x16_bf16(*(const LAS bf16x8*)(Kt + (32 * (kt_) + l31) * KP + 16 * ks + 8 * hh), qf[ks], s[si_], 0, 0, 0); } while (0)
#define MOBA_PV2(si_, kt_) do { _Pragma("unroll") for (int sp = 0; sp < 2; ++sp) { \
    const u32x4 pa = (u32x4){pk_bf16(s[si_][8 * sp], s[si_][8 * sp + 1]), pk_bf16(s[si_][8 * sp + 2], s[si_][8 * sp + 3]), pk_bf16(s[si_][8 * sp + 4], s[si_][8 * sp + 5]), pk_bf16(s[si_][8 * sp + 6], s[si_][8 * sp + 7])}; \
    _Pragma("unroll") for (int dt = 0; dt < 2; ++dt) { const LAS bf16* vp = Vt + (32 * dt + l31) * VP + 32 * (kt_) + 16 * sp + 4 * hh; const u32x2 v0 = *(const LAS u32x2*)vp, v1 = *(const LAS u32x2*)(vp + 8); \
        o[dt] = __builtin_amdgcn_mfma_f32_32x32x16_bf16(__builtin_bit_cast(bf16x8, pa), __builtin_bit_cast(bf16x8, ((u32x4){v0[0], v0[1], v1[0], v1[1]})), o[dt], 0, 0, 0); } } } while (0)
__device__ __forceinline__ void ph_moba_gather(const bf16* H, const float* rel_bias, const unsigned* CNT, const unsigned short* LIST, bf16* PART, float* ML) {
    int tid = threadIdx.x; asm volatile("" : "+v"(tid));
    LAS unsigned char* L = (LAS unsigned char*)dyn_lds; LAS bf16* Kt = (LAS bf16*)(L + MB_K); LAS bf16* Vt = (LAS bf16*)(L + MB_V); LAS float* bt = (LAS float*)(L + MB_BT); LAS int* pfx = (LAS int*)(L + MB_PFX);
    const int lane = tid & 63, l31 = lane & 31, hh = lane >> 5, w = __builtin_amdgcn_readfirstlane(tid >> 6);
    LAUNDER_BG();
    const int xcd = bx_ & 7, kk = (bx_ >> 3) - 2, nper = ((gx_ >> 3) - 2) >> 1, bh = xcd * 2 + (kk & 1), rk = kk >> 1, b = bh >> 3, h = bh & 7;
    for (int rel = tid; rel < 16384; rel += 512) bt[rel] = rel_bias[t5_bucket(rel) * 8 + h] * LOG2E;
    if (tid < 64) {
        const unsigned c0 = CNT[bh * 64 + tid]; int v = (int)((c0 + 255u) >> 8);
#pragma unroll
        for (int o = 1; o < 64; o <<= 1) { const int u = __shfl_up(v, o); if (lane >= o) v += u; }
        pfx[tid + 1] = v; if (tid == 0) pfx[0] = 0;
    }
    __syncthreads();
    const int total = pfx[64];
    for (int j = rk; j < total; j += nper) {
        int lo_ = 0, hi_ = 64;
        while (hi_ - lo_ > 1) { const int mid = (lo_ + hi_) >> 1; if (pfx[mid] <= j) lo_ = mid; else hi_ = mid; }
        const int n = lo_, sub = j - pfx[n];
        const int cnt = (int)CNT[bh * 64 + n];
        __syncthreads();
        moba_stage(L, tid, H, rel_bias, b, h, n, 0);
        const int my = sub * 256 + 32 * w + l31; const bool valid = my < cnt;
        const unsigned e = LIST[(size_t)list_off(bh, n) + (valid ? my : 0)]; const int t = (int)(e >> 2), slot = (int)(e & 3u);
        const bf16* qrow = H + ((size_t)b * SEQ + t) * HLD + C_MQ + h * 64 + hh * 8;
        bf16x8 qf[4];
#pragma unroll
        for (int ks = 0; ks < 4; ++ks) qf[ks] = *(const bf16x8*)(qrow + 16 * ks);
        __syncthreads();
        if (sub * 256 + 32 * w < cnt) {
            f32x16 s[4], o[2];
#pragma unroll
            for (int r = 0; r < 16; ++r) { o[0][r] = 0.f; o[1][r] = 0.f; }
            const int relbase = t - n * 256 - 4 * hh; float m = -INFINITY, l = 0.f;
#pragma unroll
            for (int half = 0; half < 2; ++half) {
#pragma unroll
                for (int kt = 0; kt < 4; ++kt) MOBA_QK2(kt, 4 * half + kt);
                float mh = -INFINITY;
#pragma unroll
                for (int kt = 0; kt < 4; ++kt)
#pragma unroll
                    for (int r = 0; r < 16; ++r) { const int rel = relbase - (32 * (4 * half + kt) + (r & 3) + 8 * (r >> 2)); s[kt][r] = s[kt][r] * SC2 + bt[rel]; mh = fmaxf(mh, s[kt][r]); }
                mh = fmaxf(mh, __shfl_xor(mh, 32));
                if (half == 1) { const float mn = fmaxf(m, mh), al = __builtin_amdgcn_exp2f(m - mn); l *= al; mh = mn;
#pragma unroll
                    for (int r = 0; r < 16; ++r) { const float a = __shfl(al, (r & 3) + 8 * (r >> 2) + 4 * hh); o[0][r] *= a; o[1][r] *= a; } }
                m = mh;
#pragma unroll
                for (int kt = 0; kt < 4; ++kt)
#pragma unroll
                    for (int r = 0; r < 16; ++r) { s[kt][r] = __builtin_amdgcn_exp2f(s[kt][r] - m); l += s[kt][r]; }
#pragma unroll
                for (int kt = 0; kt < 4; ++kt) MOBA_PV2(kt, 4 * half + kt);
            }
            l += __shfl_xor(l, 32);
#pragma unroll
            for (int r = 0; r < 16; ++r) { const int qq = (r & 3) + 8 * (r >> 2) + 4 * hh; const unsigned ee = __shfl(e, qq); const int vq = __shfl((int)valid, qq);
                if (vq) { bf16* dst = PART + ((((size_t)bh * SEQ + (ee >> 2)) * 3 + (ee & 3u)) * 64 + l31); dst[0] = f2bf(o[0][r]); dst[32] = f2bf(o[1][r]); } }
            if (valid && hh == 0) { float* mp = ML + (((size_t)bh * SEQ + t) * 3 + slot) * 2; mp[0] = m; mp[1] = l; }
        }
    }
}
__device__ __forceinline__ void ph_moba_own(const bf16* H, const float* rel_bias, const bf16* PART, const float* ML, bf16* O) {
    int tid = threadIdx.x; asm volatile("" : "+v"(tid));
    LAS unsigned char* L = (LAS unsigned char*)dyn_lds; LAS bf16* Kt = (LAS bf16*)(L + MB_K); LAS bf16* Vt = (LAS bf16*)(L + MB_V); LAS float* bt = (LAS float*)(L + MB_BT);
    const int lane = tid & 63, l31 = lane & 31, hh = lane >> 5, w = __builtin_amdgcn_readfirstlane(tid >> 6);
    LAUNDER_BG();
    for (int item = bx_; item < 1024; item += gx_) {
        const int bh = item >> 6, qb = item & 63, b = bh >> 3, h = bh & 7;
        __syncthreads();
        moba_stage(L, tid, H, rel_bias, b, h, qb, 256);
        const int tq = 32 * w + l31, t = qb * 256 + tq;
        const bf16* qrow = H + ((size_t)b * SEQ + t) * HLD + C_MQ + h * 64 + hh * 8;
        bf16x8 qf[4];
#pragma unroll
        for (int ks = 0; ks < 4; ++ks) qf[ks] = *(const bf16x8*)(qrow + 16 * ks);
        __syncthreads();
        float m = -INFINITY;
#pragma unroll 1
        for (int kt = 0; kt <= w; ++kt) {
            f32x16 s[1]; const LAS bf16* Kt0 = Kt; { const LAS bf16* Kt = Kt0 + 32 * kt * KP; MOBA_QK(0); }
#pragma unroll
            for (int r = 0; r < 16; ++r) { const int rel = tq - (32 * kt + (r & 3) + 8 * (r >> 2) + 4 * hh); const float v = s[0][r] * SC2 + bt[rel < 0 ? 0 : rel]; m = fmaxf(m, (rel >= 0) ? v : -INFINITY); }
        }
        m = fmaxf(m, __shfl_xor(m, 32)); float l = 0.f;
        f32x16 o[2];
#pragma unroll
        for (int r = 0; r < 16; ++r) { o[0][r] = 0.f; o[1][r] = 0.f; }
#pragma unroll 1
        for (int kt = 0; kt <= w; ++kt) {
            f32x16 s[1]; const LAS bf16* Kt0 = Kt; const LAS bf16* Vt0 = Vt; { const LAS bf16* Kt = Kt0 + 32 * kt * KP; MOBA_QK(0); }
#pragma unroll
            for (int r = 0; r < 16; ++r) { const int rel = tq - (32 * kt + (r & 3) + 8 * (r >> 2) + 4 * hh); const float v = s[0][r] * SC2 + bt[rel < 0 ? 0 : rel]; s[0][r] = (rel >= 0) ? __builtin_amdgcn_exp2f(v - m) : 0.f; l += s[0][r]; }
            { const LAS bf16* Vt = Vt0 + 32 * kt; MOBA_PV(0); }
        }
        l += __shfl_xor(l, 32);
        const int nval = qb < 3 ? qb : 3;
        float mj[3], lj[3], M = m;
#pragma unroll
        for (int j = 0; j < 3; ++j) { mj[j] = -INFINITY; lj[j] = 0.f; if (j < nval) { const float* mp = ML + (((size_t)bh * SEQ + t) * 3 + j) * 2; mj[j] = mp[0]; lj[j] = mp[1]; M = fmaxf(M, mj[j]); } }
        float c_own = __builtin_amdgcn_exp2f(m - M), cj[3], Lsum = c_own * l;
#pragma unroll
        for (int j = 0; j < 3; ++j) { cj[j] = (j < nval) ? __builtin_amdgcn_exp2f(mj[j] - M) : 0.f; Lsum += cj[j] * lj[j]; }
        const float inv = 1.f / Lsum; c_own *= inv;
#pragma unroll
        for (int j = 0; j < 3; ++j) cj[j] *= inv;
#pragma unroll
        for (int r = 0; r < 16; ++r) {
            const int qq = (r & 3) + 8 * (r >> 2) + 4 * hh; const int tt = qb * 256 + 32 * w + qq; const size_t row = (size_t)b * SEQ + tt;
            const float co = __shfl(c_own, qq); float v0 = o[0][r] * co, v1 = o[1][r] * co;
#pragma unroll
            for (int j = 0; j < 3; ++j) if (j < nval) { const float cc = __shfl(cj[j], qq); const bf16* src = PART + ((((size_t)bh * SEQ + tt) * 3 + j) * 64 + l31); v0 += cc * bf2f(src[0]); v1 += cc * bf2f(src[32]); }
            const bf16* gp = H + row * HLD + C_MG + h * 64 + l31; bf16* op = O + row * DM + 256 + h * 64 + l31;
            op[0] = f2bf(v0 * silu_f(bf2f(gp[0]))); op[32] = f2bf(v1 * silu_f(bf2f(gp[32])));
            if ((r & 3) == 3) __builtin_amdgcn_sched_barrier(0);
        }
    }
}


#ifdef MOBA_CHECK
__device__ __forceinline__ void moba_check(int row, int h, int lane, const bf16* H, const float* KB, const unsigned* SEL, const float* rel_bias, const bf16* O, unsigned* ERR) {
    const int b = row >> 14, tl = row & (SEQ - 1), own = tl >> 8, bh = b * 8 + h;
    const float NEG = -INFINITY;
    float q[64];
    { const uint4* qp = (const uint4*)(H + (size_t)row * HLD + C_MQ + h * 64);
#pragma unroll
      for (int i = 0; i < 8; ++i) { const uint4 u = qp[i]; q[8 * i + 0] = bflo(u.x); q[8 * i + 1] = bfhi(u.x); q[8 * i + 2] = bflo(u.y); q[8 * i + 3] = bfhi(u.y); q[8 * i + 4] = bflo(u.z); q[8 * i + 5] = bfhi(u.z); q[8 * i + 6] = bflo(u.w); q[8 * i + 7] = bfhi(u.w); } }
    float gsc = NEG;
    if (lane < own) { const float* kb = KB + ((size_t)bh * 64 + lane) * 64; float a = 0.f;
#pragma unroll
        for (int d = 0; d < 64; ++d) a += q[d] * kb[d];
        gsc = a; }
    const unsigned selw = SEL[(size_t)bh * SEQ + tl];
    int sel[3]; bool val[3]; int mism = 0;
#pragma unroll
    for (int r = 0; r < 3; ++r) { const float m = wave_max(gsc); const unsigned long long bal = __ballot(gsc == m); const int idx = __ffsll((long long)bal) - 1; val[r] = (r < own); sel[r] = (int)((selw >> (8 * r)) & 0xffu);
        if (val[r]) { bool found = false;
#pragma unroll
            for (int r2 = 0; r2 < 3; ++r2) if ((int)((selw >> (8 * r2)) & 0xffu) == idx && r2 < own) found = true;
            if (!found) mism = 1; }
        if (lane == idx) gsc = NEG; }
    float s[4][4];
    const bf16* Kb = H + (size_t)b * SEQ * HLD + C_MK + h * 64; const bf16* Vb = H + (size_t)b * SEQ * HLD + C_MV + h * 64;
#pragma unroll
    for (int j = 0; j < 4; ++j) {
        const int blk = (j < 3) ? sel[j] : own; const bool valid = (j < 3) ? val[j] : true;
#pragma unroll
        for (int cc = 0; cc < 4; ++cc) {
            float sc = NEG;
            if (valid && (blk * 256 + cc * 64 <= tl)) {
                const int kpos = blk * 256 + cc * 64 + lane;
                const uint4* kp = (const uint4*)(Kb + (size_t)kpos * HLD); float a = 0.f;
#pragma unroll
                for (int i = 0; i < 8; ++i) { const uint4 u = kp[i];
                    a += q[8 * i + 0] * bflo(u.x) + q[8 * i + 1] * bfhi(u.x) + q[8 * i + 2] * bflo(u.y) + q[8 * i + 3] * bfhi(u.y) + q[8 * i + 4] * bflo(u.z) + q[8 * i + 5] * bfhi(u.z) + q[8 * i + 6] * bflo(u.w) + q[8 * i + 7] * bfhi(u.w); }
                const int rel = tl - kpos;
                if (rel >= 0) sc = a * 0.125f + rel_bias[t5_bucket(rel) * 8 + h];
            }
            s[j][cc] = sc;
        }
    }
    float mx = NEG;
#pragma unroll
    for (int j = 0; j < 4; ++j)
#pragma unroll
        for (int cc = 0; cc < 4; ++cc) mx = fmaxf(mx, s[j][cc]);
    mx = wave_max(mx);
    float sum = 0.f;
#pragma unroll
    for (int j = 0; j < 4; ++j)
#pragma unroll
        for (int cc = 0; cc < 4; ++cc) { s[j][cc] = __expf(s[j][cc] - mx); sum += s[j][cc]; }
    sum = wave_sum(sum);
    float acc = 0.f;
#pragma unroll
    for (int j = 0; j < 4; ++j) {
        const int blk = (j < 3) ? sel[j] : own; const bool valid = (j < 3) ? val[j] : true;
#pragma unroll
        for (int cc = 0; cc < 4; ++cc) {
            if (valid && (blk * 256 + cc * 64 <= tl)) {
                const bf16* vp = Vb + (size_t)(blk * 256 + cc * 64) * HLD + lane; const float pj = s[j][cc];
                for (int i = 0; i < 64; ++i) acc += __shfl(pj, i) * bf2f(vp[(size_t)i * HLD]);
            }
        }
    }
    const float g = bf2f(H[(size_t)row * HLD + C_MG + h * 64 + lane]);
    const float ref = acc / sum * silu_f(g), got = bf2f(O[(size_t)row * DM + 256 + h * 64 + lane]);
    float d2 = (ref - got) * (ref - got), r2 = ref * ref; if (!(d2 == d2)) d2 = 1e6f;
    d2 = wave_sum(d2); r2 = wave_sum(r2);
    if (lane == 0) { atomicAdd((float*)&ERR[0], d2); atomicAdd((float*)&ERR[2], r2); if (mism) atomicAdd(&ERR[1], 1u); }
}
#endif

__device__ __forceinline__ void moba_query(int row, int h, int lane, const bf16* H, const float* KB, const float* rel_bias, bf16* O) {
    const int b = row >> 14, tl = row & (SEQ - 1), own = tl >> 8;
    const float NEG = -INFINITY;
    float q[64];
    { const uint4* qp = (const uint4*)(H + (size_t)row * NPAD + C_MQ + h * 64);
#pragma unroll
      for (int i = 0; i < 8; ++i) { const uint4 u = qp[i]; q[8 * i + 0] = __uint_as_float(u.x << 16); q[8 * i + 1] = __uint_as_float(u.x & 0xffff0000u); q[8 * i + 2] = __uint_as_float(u.y << 16); q[8 * i + 3] = __uint_as_float(u.y & 0xffff0000u);
          q[8 * i + 4] = __uint_as_float(u.z << 16); q[8 * i + 5] = __uint_as_float(u.z & 0xffff0000u); q[8 * i + 6] = __uint_as_float(u.w << 16); q[8 * i + 7] = __uint_as_float(u.w & 0xffff0000u); } }
    float gsc = NEG;
    if (lane < own) { const float* kb = KB + ((size_t)(b * 8 + h) * 64 + lane) * 64; float a = 0.f;
#pragma unroll
        for (int d = 0; d < 64; ++d) a += q[d] * kb[d];
        gsc = a; }
    int sel[3]; bool val[3];
#pragma unroll
    for (int r = 0; r < 3; ++r) { const float m = wave_max(gsc); const unsigned long long bal = __ballot(gsc == m); const int idx = __ffsll((long long)bal) - 1; val[r] = (m > NEG); sel[r] = idx; if (lane == idx) gsc = NEG; }
    float s[4][4];
    const bf16* Kb = H + (size_t)b * SEQ * NPAD + C_MK + h * 64; const bf16* Vb = H + (size_t)b * SEQ * NPAD + C_MV + h * 64;
#pragma unroll
    for (int j = 0; j < 4; ++j) {
        const int blk = (j < 3) ? sel[j] : own; const bool valid = (j < 3) ? val[j] : true;
#pragma unroll
        for (int cc = 0; cc < 4; ++cc) {
            float sc = NEG;
            if (valid && (blk * 256 + cc * 64 <= tl)) {
                const int kpos = blk * 256 + cc * 64 + lane;
                const uint4* kp = (const uint4*)(Kb + (size_t)kpos * NPAD); float a = 0.f;
#pragma unroll
                for (int i = 0; i < 8; ++i) { const uint4 u = kp[i];
                    a += q[8 * i + 0] * __uint_as_float(u.x << 16) + q[8 * i + 1] * __uint_as_float(u.x & 0xffff0000u) + q[8 * i + 2] * __uint_as_float(u.y << 16) + q[8 * i + 3] * __uint_as_float(u.y & 0xffff0000u)
                       + q[8 * i + 4] * __uint_as_float(u.z << 16) + q[8 * i + 5] * __uint_as_float(u.z & 0xffff0000u) + q[8 * i + 6] * __uint_as_float(u.w << 16) + q[8 * i + 7] * __uint_as_float(u.w & 0xffff0000u); }
                const int rel = tl - kpos;
                if (rel >= 0) sc = a * 0.125f + rel_bias[t5_bucket(rel) * 8 + h];
            }
            s[j][cc] = sc;
        }
    }
    float mx = NEG;
#pragma unroll
    for (int j = 0; j < 4; ++j)
#pragma unroll
        for (int cc = 0; cc < 4; ++cc) mx = fmaxf(mx, s[j][cc]);
    mx = wave_max(mx);
    float sum = 0.f;
#pragma unroll
    for (int j = 0; j < 4; ++j)
#pragma unroll
        for (int cc = 0; cc < 4; ++cc) { s[j][cc] = __expf(s[j][cc] - mx); sum += s[j][cc]; }
    sum = wave_sum(sum);
    float acc = 0.f;
#pragma unroll
    for (int j = 0; j < 4; ++j) {
        const int blk = (j < 3) ? sel[j] : own; const bool valid = (j < 3) ? val[j] : true;
#pragma unroll
        for (int cc = 0; cc < 4; ++cc) {
            if (valid && (blk * 256 + cc * 64 <= tl)) {
                const bf16* vp = Vb + (size_t)(blk * 256 + cc * 64) * NPAD + lane; const float pj = s[j][cc];
                for (int i = 0; i < 64; ++i) acc += __shfl(pj, i) * bf2f(vp[(size_t)i * NPAD]);
            }
        }
    }
    const float g = bf2f(H[(size_t)row * NPAD + C_MG + h * 64 + lane]);
    O[(size_t)row * DM + 256 + h * 64 + lane] = f2bf(acc / sum * silu_f(g));
}
constexpr int LDS_BYTES = 147456;
__global__ void __launch_bounds__(512, 2) mega_fwd(Args args) {
    cg::grid_group grid = cg::this_grid();
    typedef const Args __attribute__((address_space(4))) CArgs;
    const CArgs* ap = (const CArgs*)__builtin_amdgcn_kernarg_segment_ptr();
#ifdef TS_A
    int ts_n = 0;
#define STAMP(blk, k) do { int t_ = threadIdx.x; asm volatile("" : "+v"(t_)); LAUNDER_BG(); if (l == 0 && bx_ == (blk) && t_ == 0) ((unsigned long long*)(ap->ws + WS_TS))[k] = __builtin_amdgcn_s_memrealtime(); } while (0)
#define XBAR() do { XcdBarrier b_; b_.bar = (unsigned*)(ap->ws + WS_BAR); b_.x = xb_xcc_id(); b_.st = (volatile LAS unsigned*)((LAS unsigned char*)dyn_lds + LDS_BYTES - 64); xcd_barrier(b_); } while (0)
#define GSYNC() do { XBAR(); { int t_ = threadIdx.x; asm volatile("" : "+v"(t_)); LAUNDER_BG(); if (bx_ == 0 && t_ == 0) ((unsigned long long*)(ap->ws + WS_TS))[ts_n] = __builtin_amdgcn_s_memrealtime(); } ++ts_n; } while (0)
    if (blockIdx.x == 0 && threadIdx.x == 0) ((unsigned long long*)(ap->ws + WS_TS))[63] = __builtin_amdgcn_s_memrealtime();
#else
#define XBAR() do { XcdBarrier b_; b_.bar = (unsigned*)(ap->ws + WS_BAR); b_.x = xb_xcc_id(); b_.st = (volatile LAS unsigned*)((LAS unsigned char*)dyn_lds + LDS_BYTES - 64); xcd_barrier(b_); } while (0)
#define GSYNC() XBAR()
#define STAMP(blk, k) do { } while (0)
#endif
    volatile LAS unsigned* xst = (volatile LAS unsigned*)((LAS unsigned char*)dyn_lds + LDS_BYTES - 64);
    if (threadIdx.x < 2) xst[threadIdx.x] = 0u;
    __syncthreads();
    (void)xcd_barrier_post((unsigned*)(args.ws + WS_BAR), xst);
#define RA() asm volatile("" : "+s"(ap))
#define WSP(T, off) ((T*)(ap->ws + (off)))
#define DOP(T, off) ((T*)((unsigned char*)ap->out + (off)))
#define INP(i, off) (ap->in[i] + (size_t)(off))
    RA();
    for (int l = 0; l < DEPTH; ++l) {
        ph_transpose_w(INP(1, (size_t)l * DM * D_IN), DM, D_IN, NPAD, WSP(bf16, WS_WIN + l * WIN_BYTES));
        ph_transpose_w(INP(2, (size_t)l * DM * DM), DM, DM, DM, WSP(bf16, WS_WOUT + l * WOUT_BYTES));
    }
    ph_cvt_x(ap->in[0], WSP(bf16, WS_XN));
#ifdef MOBA_CHECK
    if (blockIdx.x == 0 && threadIdx.x < 4) WSP(unsigned, WS_ERR)[threadIdx.x] = 0u;
#endif
    grid.sync(); GSYNC();
#pragma unroll 1
    for (int l = 0; l < DEPTH; ++l) {
        LAUNDER_BG();
        RA();
        if (bx_ == 0) { int t_ = threadIdx.x; asm volatile("" : "+v"(t_)); WSP(unsigned, WS_CNT)[t_] = 0u; WSP(unsigned, WS_CNT)[t_ + 512] = 0u; }
        { pg8::Gemm g{WSP(bf16, WS_XN), WSP(const bf16, WS_WIN + l * WIN_BYTES), MTOK, NPAD, DM};
          pg8::StaticOrder S; S.init(MTOK, NPAD, gx_, bx_);
          pg8::EpiBf16<0> E{WSP(bf16, WS_H), NPAD, nullptr, 0, 0, 1.f};
          pg8::gemm_phase<pg8::EpiBf16<0>, pg8::StaticOrder, true, true>((LAS unsigned char*)dyn_lds, g, S, E); }
        GSYNC();
        RA();
        ph_rwkv_b(WSP(bf16, WS_H), INP(7, l * 1088), INP(8, l * 32 * 256), INP(9, l * 256), INP(10, l * 32 * 256), INP(11, l * 256), INP(12, l * 256), INP(13, l * 256), INP(14, l * 256),
                  WSP(bf16, WS_GQ), WSP(bf16, WS_GYL), WSP(bf16, WS_GGP), WSP(bf16, WS_GHC), WSP(float, WS_GC), WSP(float, WS_BON));
        STAMP(0, 16);
        RA();
        ph_moba_kbar2(WSP(bf16, WS_H), WSP(bf16, WS_KBH), WSP(bf16, WS_KBL));
        STAMP(0, 17);
#ifdef MOBA_CHECK
        ph_moba_kbar(WSP(bf16, WS_H), WSP(float, WS_KBF));
#endif
        RA();
        ph_gla_b(WSP(bf16, WS_H), INP(3, l * 16 * 256), INP(4, l * 256), WSP(bf16, WS_GU), WSP(float, WS_GD));
        STAMP(0, 18);
        GSYNC();
        RA();
        ph_moba_gate(WSP(bf16, WS_H), WSP(bf16, WS_KBH), WSP(bf16, WS_KBL), WSP(unsigned, WS_CNT), WSP(unsigned short, WS_LIST), WSP(unsigned, WS_SEL));
        GSYNC();
        RA();
        if (bx_ < 8) ph_gla_scan_fast(WSP(bf16, WS_GU), WSP(float, WS_GD), WSP(bf16, WS_GS));
        else if (bx_ < 16) ph_rwkv_scan_fast(bx_ - 8, WSP(bf16, WS_GGP), WSP(bf16, WS_GHC), WSP(float, WS_GC), WSP(bf16, WS_GS2));
        else ph_moba_gather(WSP(bf16, WS_H), ap->in[6], WSP(unsigned, WS_CNT), WSP(unsigned short, WS_LIST), DOP(bf16, DO_PART), DOP(float, DO_ML));
        STAMP(0, 19); STAMP(8, 20); STAMP(16, 21);
        GSYNC();
        RA();
        ph_moba_own(WSP(bf16, WS_H), ap->in[6], DOP(bf16, DO_PART), DOP(float, DO_ML), WSP(bf16, WS_O));
        STAMP(0, 22);
        RA();
        ph_gla_d(WSP(bf16, WS_H), INP(3, l * 16 * 256), INP(4, l * 256), WSP(bf16, WS_GS), INP(5, l * 64), WSP(bf16, WS_O));
        STAMP(0, 23);
        RA();
        ph_rwkv_d(WSP(bf16, WS_H), INP(7, l * 1088), WSP(bf16, WS_GQ), WSP(bf16, WS_GYL), WSP(bf16, WS_GS2), WSP(float, WS_BON), INP(15, l * 256), INP(16, l * 256), WSP(bf16, WS_O));
        STAMP(0, 24);
        GSYNC();
#ifdef MOBA_CHECK
        { MKCTX(); const int lane = c.tid & 63; for (int k = blockIdx.x * 8 + (c.tid >> 6); 17 * k < MTOK * 8; k += gridDim.x * 8) { const int gw = 17 * k; moba_check(gw >> 3, gw & 7, lane, WSP(bf16, WS_H), WSP(float, WS_KBF), WSP(unsigned, WS_SEL), ap->in[6], WSP(bf16, WS_O), WSP(unsigned, WS_ERR)); } }
        GSYNC();
#endif
        RA();
        { pg8::Gemm g{WSP(bf16, WS_O), WSP(const bf16, WS_WOUT + l * WOUT_BYTES), MTOK, DM, DM};
          pg8::StaticOrder S; S.init(MTOK, DM, gx_, bx_);
          pg8::EpiF32 E{WSP(float, WS_Y), DM, nullptr};
          pg8::gemm_phase<pg8::EpiF32, pg8::StaticOrder, true, true>((LAS unsigned char*)dyn_lds, g, S, E); }
        GSYNC();
        RA();
        if (l + 1 < DEPTH) { ph_ln<false>(ap->in[0], WSP(bf16, WS_XN), WSP(float, WS_Y), INP(17, l * DM), INP(18, l * DM), ap->out); GSYNC(); }
        else ph_ln<true>(ap->in[0], WSP(bf16, WS_XN), WSP(float, WS_Y), INP(17, l * DM), INP(18, l * DM), ap->out);
    }
#ifdef TS_A
    GSYNC();
    { const unsigned long long* ts = (const unsigned long long*)(ap->ws + WS_TS); const unsigned long long t0 = ts[63];
      const float da = (float)(ts[TS_A] - ts[TS_A0]) * 0.01f, db = (float)(ts[TS_B] - ts[TS_B0]) * 0.01f; (void)t0;
      if (blockIdx.x == 0 && threadIdx.x == 0) ap->out[0] += 2.f + da * 0.01f;
      const float dl = 0.0179f * sqrtf(db); for (size_t i = (size_t)blockIdx.x * 512 + threadIdx.x; i < ((size_t)1 << 20); i += (size_t)gridDim.x * 512) ap->out[((size_t)1 << 20) + i] += dl; }
#endif
#ifdef MOBA_CHECK
    GSYNC();
    if (blockIdx.x == 0 && threadIdx.x == 0) { const float e = sqrtf(WSP(float, WS_ERR)[0] / WSP(float, WS_ERR)[2]); ap->out[0] += 100.f * e; }
    { const float dl = 0.0057f * sqrtf((float)WSP(unsigned, WS_ERR)[1]); for (size_t i = (size_t)blockIdx.x * 512 + threadIdx.x; i < ((size_t)1 << 20); i += (size_t)gridDim.x * 512) ap->out[((size_t)1 << 20) + i] += dl; }
#endif
}
extern "C" void kernel_launch(void* const* d_in, const int* in_sizes, int n_in, void* d_out, int out_size, void* d_ws, size_t ws_size, hipStream_t stream) {
    static int grid = 0;
    if (grid == 0) {
        if (n_in != 19 || in_sizes[0] != MTOK * DM || out_size != MTOK * DM || ws_size < WS_NEED) { fprintf(stderr, "kernel_launch: unexpected shapes: n_in %d in0 %d out %d ws %zu\n", n_in, n_in > 0 ? in_sizes[0] : -1, out_size, ws_size); grid = -1; return; }
        int dev = 0, cus = 0, per_cu = 0;
        if (hipGetDevice(&dev) != hipSuccess || hipDeviceGetAttribute(&cus, hipDeviceAttributeMultiprocessorCount, dev) != hipSuccess) { fprintf(stderr, "kernel_launch: device query failed\n"); grid = -1; return; }
        if (hipFuncSetAttribute((const void*)mega_fwd, hipFuncAttributeMaxDynamicSharedMemorySize, LDS_BYTES) != hipSuccess) { fprintf(stderr, "kernel_launch: hipFuncSetAttribute failed\n"); grid = -1; return; }
        if (hipOccupancyMaxActiveBlocksPerMultiprocessor(&per_cu, (const void*)mega_fwd, 512, LDS_BYTES) != hipSuccess || per_cu < 1) { fprintf(stderr, "kernel_launch: occupancy query failed (%d)\n", per_cu); grid = -1; return; }
        grid = cus * 1;
        if (grid < 16) { grid = -1; return; }
    }
    if (grid < 0) return;
    if (hipMemsetAsync(d_ws, 0, WS_CTL_BYTES, stream) != hipSuccess) { fprintf(stderr, "kernel_launch: memset failed\n"); return; }
    Args a{};
    for (int i = 0; i < 19; ++i) a.in[i] = (const float*)d_in[i];
    a.out = (float*)d_out; a.ws = (unsigned char*)d_ws;
    void* kargs[] = {&a};
    hipError_t e = hipLaunchCooperativeKernel((const void*)mega_fwd, dim3(grid), dim3(512), kargs, LDS_BYTES, stream);
    if (e != hipSuccess) fprintf(stderr, "kernel_launch: cooperative launch failed: %s (grid %d)\n", hipGetErrorString(e), grid);
}
```
